# Optimizing an MI355X kernel written in HIP

```python
import jax, jax.numpy as jnp
from jax import lax
import numpy as np

D_MODEL = 1024
BATCH = 8
SEQ = 8192
DEPTH = 2

CHUNK = 64
NORM_EPS = 1e-6
HG_HEADS = 4
HG_DK = 128
HG_DV = 128
HG_WIDTH = HG_HEADS * HG_DV
GLA_HEADS = 4
GLA_DK = 64
GLA_DV = 128
GLA_RANK = 16
GLA_GATE_NORMALIZER = 16.0
GLA_WIDTH = GLA_HEADS * GLA_DV
DN_HEADS = 4
DN_DK = 128
DN_DV = 128
DN_CONV = 4
DN_WIDTH = DN_HEADS * DN_DV
BRANCH_WIDTH = 512
N_BRANCH = 3
FFN_HIDDEN = 2816
FFN_CONV = 3
IN_SPLITS = (
    HG_HEADS * HG_DK,
    HG_HEADS * HG_DK,
    HG_WIDTH,
    HG_WIDTH,
    GLA_HEADS * GLA_DK,
    GLA_HEADS * GLA_DK,
    GLA_WIDTH,
    GLA_RANK,
    GLA_WIDTH,
    DN_HEADS * (2 * DN_DK + DN_DV),
    DN_WIDTH,
    DN_HEADS,
    DN_HEADS,
    N_BRANCH * D_MODEL,
)
IN_WIDTH = 2048 + 1552 + 2056 + N_BRANCH * D_MODEL

kernel_name = 'hybrid_hgrn2_gla_gdn_convffn'


def rms_norm(x, g):
    x32 = x.astype(jnp.float32)
    y = x32 * lax.rsqrt(jnp.mean(x32 * x32, axis=-1, keepdims=True) + NORM_EPS)
    return (y * g.astype(jnp.float32)).astype(x.dtype)


def l2_norm(x):
    x32 = x.astype(jnp.float32)
    return x32 * lax.rsqrt(jnp.sum(x32 * x32, axis=-1, keepdims=True) + NORM_EPS)


def gated_head_norm(o, z, g):
    B, S, H, dv = o.shape
    return (rms_norm(o, g) * jax.nn.silu(z.reshape(B, S, H, dv))).reshape(B, S, H * dv)


def causal_dwconv(x, w):
    W = w.shape[0]
    S = x.shape[1]
    xp = jnp.pad(x, ((0, 0), (W - 1, 0), (0, 0)))
    return sum(xp[:, j:j + S, :] * w[j] for j in range(W))


def to_chunks(t):
    B, S, H, d = t.shape
    return t.reshape(B, S // CHUNK, CHUNK, H, d).transpose(0, 3, 1, 2, 4)


def from_chunks(t):
    B, H, N, C, d = t.shape
    return t.transpose(0, 2, 3, 1, 4).reshape(B, N * C, H, d)


def chunk_gla(q, k, v, log_f, scale):
    out_dtype = v.dtype
    f32 = jnp.float32
    qc, kc, vc, gc = (jnp.moveaxis(to_chunks(t.astype(f32)), 2, 0)
                      for t in (q.astype(f32) * scale, k, v, log_f))
    B, H, dk, dv = qc.shape[1], qc.shape[2], qc.shape[-1], vc.shape[-1]
    causal = jnp.tril(jnp.ones((CHUNK, CHUNK), dtype=bool))[:, :, None]

    def step(state, inp):
        q_, k_, v_, g_ = inp
        b = jnp.cumsum(g_, axis=-2)
        decay = jnp.exp(jnp.where(causal, b[..., :, None, :] - b[..., None, :, :], -jnp.inf))
        scores = jnp.einsum('bhtsd,bhsd->bhts', q_[..., :, None, :] * decay, k_)
        o = (jnp.einsum('bhtd,bhdv->bhtv', q_ * jnp.exp(b), state)
             + jnp.einsum('bhts,bhsv->bhtv', scores, v_))
        b_last = b[..., -1:, :]
        state = (state * jnp.exp(b_last)[..., 0, :, None]
                 + jnp.einsum('bhsd,bhsv->bhdv', k_ * jnp.exp(b_last - b), v_))
        return state, o

    state0 = jnp.zeros((B, H, dk, dv), f32)
    _, o = lax.scan(step, state0, (qc, kc, vc, gc))
    return from_chunks(jnp.moveaxis(o, 0, 2)).astype(out_dtype)


def chunk_gated_delta(q, k, v, g, beta):
    out_dtype = v.dtype
    f32 = jnp.float32
    q, k, v = (to_chunks(t.astype(f32)) for t in (q, k, v))
    g = to_chunks(g.astype(f32)[..., None])[..., 0]
    beta = to_chunks(beta.astype(f32)[..., None])[..., 0]
    G = jnp.cumsum(g, axis=-1)
    incl = jnp.tril(jnp.ones((CHUNK, CHUNK), dtype=bool))
    strict = jnp.tril(jnp.ones((CHUNK, CHUNK), dtype=bool), -1)
    L = jnp.exp(jnp.where(incl, G[..., :, None] - G[..., None, :], -jnp.inf))
    kb = k * beta[..., None]
    M = jnp.where(strict, jnp.einsum('bhntd,bhnsd->bhnts', kb, k) * L, 0.0)
    eye = jnp.eye(CHUNK, dtype=f32)
    rhs = jnp.concatenate([v * beta[..., None], kb * jnp.exp(G)[..., None]], axis=-1)
    sol = lax.linalg.triangular_solve(M + eye, rhs, left_side=True, lower=True,
                                      unit_diagonal=True)
    dv = v.shape[-1]
    u, w = sol[..., :dv], sol[..., dv:]
    scores = jnp.where(incl, jnp.einsum('bhntd,bhnsd->bhnts', q, k) * L, 0.0)
    q_dec = q * jnp.exp(G)[..., None]
    k_dec = k * jnp.exp(G[..., -1:] - G)[..., None]
    chunk_decay = jnp.exp(G[..., -1])
    xs = tuple(jnp.moveaxis(t, 2, 0) for t in (u, w, q_dec, scores, k_dec, chunk_decay))
    B, H, dk = q.shape[0], q.shape[1], q.shape[-1]

    def step(state, inp):
        u_, w_, qd_, sc_, kd_, cd_ = inp
        v_new = u_ - jnp.einsum('bhcd,bhdv->bhcv', w_, state)
        o = (jnp.einsum('bhcd,bhdv->bhcv', qd_, state)
             + jnp.einsum('bhts,bhsv->bhtv', sc_, v_new))
        state = state * cd_[..., None, None] + jnp.einsum('bhcd,bhcv->bhdv', kd_, v_new)
        return state, o

    state0 = jnp.zeros((B, H, dk, dv), f32)
    _, o = lax.scan(step, state0, xs)
    return from_chunks(jnp.moveaxis(o, 0, 2)).astype(out_dtype)


def token_mixer(h, w_in, lb, hg_norm_g, gla_gk_w2, gla_gk_b, gla_norm_g, dn_conv_w,
                dn_A_log, dn_dt_bias, dn_norm_g, w_branch, gate_b, w_out):
    B, S, _ = h.shape
    f32 = jnp.float32
    proj = h @ w_in
    idx = [int(i) for i in np.cumsum(IN_SPLITS)[:-1]]
    (hg_q, hg_f, hg_i, hg_g, gla_q, gla_k, gla_v, gla_gk, gla_g,
     dn_qkv, dn_z, dn_b, dn_a, gates) = jnp.split(proj, idx, axis=-1)

    lb = lb.reshape(HG_HEADS, HG_DK)
    zf = hg_f.reshape(B, S, HG_HEADS, HG_DK).astype(f32)
    log_f = jnp.logaddexp(jnp.log(lb), jnp.log1p(-lb) + jax.nn.log_sigmoid(zf))
    k_hg = (1.0 - lb) * jax.nn.sigmoid(-zf)
    q_hg = jax.nn.silu(hg_q).reshape(B, S, HG_HEADS, HG_DK)
    o = chunk_gla(q_hg, k_hg, hg_i.reshape(B, S, HG_HEADS, HG_DV), log_f, HG_DK ** -0.5)
    o_hg = gated_head_norm(o, hg_g, hg_norm_g)

    gk = (gla_gk @ gla_gk_w2 + gla_gk_b).astype(f32)
    log_a = jax.nn.log_sigmoid(gk).reshape(B, S, GLA_HEADS, GLA_DK) / GLA_GATE_NORMALIZER
    o = chunk_gla(gla_q.reshape(B, S, GLA_HEADS, GLA_DK), gla_k.reshape(B, S, GLA_HEADS, GLA_DK),
                  gla_v.reshape(B, S, GLA_HEADS, GLA_DV), log_a, GLA_DK ** -0.5)
    o_gla = gated_head_norm(o, gla_g, gla_norm_g)

    qkv = jax.nn.silu(causal_dwconv(dn_qkv, dn_conv_w))
    q_dn, k_dn, v_dn = jnp.split(qkv, [DN_HEADS * DN_DK, 2 * DN_HEADS * DN_DK], axis=-1)
    q_dn = l2_norm(q_dn.reshape(B, S, DN_HEADS, DN_DK)) * (DN_DK ** -0.5)
    k_dn = l2_norm(k_dn.reshape(B, S, DN_HEADS, DN_DK))
    beta = jax.nn.sigmoid(dn_b.astype(f32))
    g_dn = -jnp.exp(dn_A_log.astype(f32)) * jax.nn.softplus(dn_a.astype(f32) + dn_dt_bias.astype(f32))
    o = chunk_gated_delta(q_dn, k_dn, v_dn.reshape(B, S, DN_HEADS, DN_DV), g_dn, beta)
    o_dn = gated_head_norm(o, dn_z, dn_norm_g)

    gates = jax.nn.sigmoid(gates + gate_b).reshape(B, S, N_BRANCH, D_MODEL)
    merged = sum(gates[:, :, n, :] * (o_n @ w_branch[n])
                 for n, o_n in enumerate((o_hg, o_gla, o_dn)))
    return merged @ w_out


def conv_ffn(h, w_up, conv_w, conv_b, w_down):
    u = causal_dwconv(h @ w_up, conv_w) + conv_b
    a, b = jnp.split(u, 2, axis=-1)
    return (jax.nn.silu(a) * b) @ w_down


def setup_inputs(seed: int = 0) -> dict:
    key = jax.random.key(seed)
    ks = jax.random.split(key, 24)
    f32 = jnp.float32

    def nrm(k, shape, scale):
        return jax.random.normal(k, shape, f32) * scale

    dt = jnp.exp(jax.random.uniform(ks[10], (DEPTH, DN_HEADS), f32,
                                    jnp.log(0.001), jnp.log(0.1)))
    return {
        'x': nrm(ks[0], (BATCH, SEQ, D_MODEL), 1.0),
        'norm_mix_g': 1.0 + nrm(ks[1], (DEPTH, D_MODEL), 0.02),
        'w_in': nrm(ks[2], (DEPTH, D_MODEL, IN_WIDTH), D_MODEL ** -0.5),
        'hg_lower_bounds': nrm(ks[3], (DEPTH, HG_HEADS * HG_DK), 0.1),
        'hg_norm_g': 1.0 + nrm(ks[4], (DEPTH, HG_DV), 0.02),
        'gla_gk_w2': nrm(ks[5], (DEPTH, GLA_RANK, GLA_HEADS * GLA_DK), GLA_RANK ** -0.5),
        'gla_gk_b': nrm(ks[6], (DEPTH, GLA_HEADS * GLA_DK), 0.01),
        'gla_norm_g': 1.0 + nrm(ks[7], (DEPTH, GLA_DV), 0.02),
        'dn_conv_w': nrm(ks[8], (DEPTH, DN_CONV, DN_HEADS * (2 * DN_DK + DN_DV)), DN_CONV ** -0.5),
        'dn_A_log': jnp.log(jax.random.uniform(ks[9], (DEPTH, DN_HEADS), f32, 1.0, 16.0)),
        'dn_dt_bias': dt + jnp.log(-jnp.expm1(-dt)),
        'dn_norm_g': 1.0 + nrm(ks[11], (DEPTH, DN_DV), 0.02),
        'w_branch': nrm(ks[12], (DEPTH, N_BRANCH, BRANCH_WIDTH, D_MODEL), BRANCH_WIDTH ** -0.5),
        'gate_b': nrm(ks[13], (DEPTH, N_BRANCH * D_MODEL), 0.01),
        'w_out': nrm(ks[14], (DEPTH, D_MODEL, D_MODEL), D_MODEL ** -0.5),
        'norm_ffn_g': 1.0 + nrm(ks[15], (DEPTH, D_MODEL), 0.02),
        'w_up': nrm(ks[16], (DEPTH, D_MODEL, 2 * FFN_HIDDEN), D_MODEL ** -0.5),
        'ffn_conv_w': nrm(ks[17], (DEPTH, FFN_CONV, 2 * FFN_HIDDEN), FFN_CONV ** -0.5),
        'ffn_conv_b': nrm(ks[18], (DEPTH, 2 * FFN_HIDDEN), 0.01),
        'w_down': nrm(ks[19], (DEPTH, FFN_HIDDEN, D_MODEL), FFN_HIDDEN ** -0.5),
        'norm_final_g': 1.0 + nrm(ks[20], (D_MODEL,), 0.02),
    }


def reference(x, norm_mix_g, w_in, hg_lower_bounds, hg_norm_g, gla_gk_w2, gla_gk_b,
              gla_norm_g, dn_conv_w, dn_A_log, dn_dt_bias, dn_norm_g, w_branch, gate_b,
              w_out, norm_ffn_g, w_up, ffn_conv_w, ffn_conv_b, w_down, norm_final_g):
    lb_all = jnp.cumsum(jax.nn.softmax(hg_lower_bounds.astype(jnp.float32), axis=0), axis=0)
    lb_all = lb_all - lb_all[:1]
    for l in range(DEPTH):
        h = rms_norm(x, norm_mix_g[l])
        x = x + token_mixer(h, w_in[l], lb_all[l], hg_norm_g[l], gla_gk_w2[l], gla_gk_b[l],
                            gla_norm_g[l], dn_conv_w[l], dn_A_log[l], dn_dt_bias[l],
                            dn_norm_g[l], w_branch[l], gate_b[l], w_out[l])
        h = rms_norm(x, norm_ffn_g[l])
        x = x + conv_ffn(h, w_up[l], ffn_conv_w[l], ffn_conv_b[l], w_down[l])
    return rms_norm(x, norm_final_g)
```

```cpp
#include <hip/hip_runtime.h>
#include <hip/hip_cooperative_groups.h>
#include <cstdio>
#include <cstdint>
namespace cg = cooperative_groups;
#ifndef CH_GLA
#define CH_GLA 1
#endif
#ifndef CH_GDN
#define CH_GDN 1
#endif

#define LAS __attribute__((address_space(3)))
typedef unsigned short bf16_t;
typedef short bf16x8 __attribute__((ext_vector_type(8)));
typedef float f32x4 __attribute__((ext_vector_type(4)));
typedef unsigned u32x4 __attribute__((ext_vector_type(4)));
typedef unsigned u32x2 __attribute__((ext_vector_type(2)));

constexpr int T = 65536, DM = 1024, SEQ = 8192, NBATCH = 8, DEPTH = 2;
constexpr int PLD = 5888;
constexpr int NMIXCOL = 5656, INW = 8728;
constexpr int FFH = 2816, UPN = 5632;
constexpr int TH = T / 2;
constexpr float EPS = 1e-6f;
constexpr int C_HGQ = 0, C_HGF = 512, C_HGI = 1024, C_HGG = 1536, C_GLQ = 2048, C_GLK = 2304, C_GLV = 2560, C_GLGK = 3072, C_GLG = 3088,
              C_DNQ = 3600, C_DNK = 4112, C_DNV = 4624, C_DNZ = 5136, C_DNB = 5648, C_DNA = 5652;
constexpr int C_GATE0 = 0, C_GATE1 = 1536, C_GATE2 = 3072;

constexpr size_t MiB = 1u << 20;
constexpr size_t LW_WIN = 0, LW_WG = LW_WIN + (size_t)PLD * DM * 2, LW_WBR = LW_WG + (size_t)3072 * DM * 2, LW_WOUT = LW_WBR + (size_t)3 * DM * 512 * 2,
                 LW_WUP = LW_WOUT + (size_t)DM * DM * 2, LW_WDN = LW_WUP + (size_t)UPN * DM * 2, LW_BYTES = LW_WDN + (size_t)DM * FFH * 2;
static_assert(LW_BYTES == 39 * MiB, "layer weight block");
constexpr size_t WS_W = 0, WS_HB = 80 * MiB, WS_PROJ = 208 * MiB, WS_ODN = 944 * MiB, WS_END = 1008 * MiB;
constexpr size_t WS_CTL = 1008 * MiB, CTL_BYTES = 16384;
constexpr size_t WS_HALO = 1009 * MiB;
constexpr int HALO_C0 = 3584, HALO_LD = 1792;
static_assert(WS_HALO + (size_t)(T / 64) * 3 * HALO_LD * 2 <= 1020 * MiB, "halo map");
constexpr size_t WS_DEC = 1020 * MiB;
constexpr size_t DEC_GLA_OFF = 2 * MiB, DEC_GDN_OFF = 3 * MiB;
constexpr size_t WS_SSQ1 = 78 * MiB, WS_SSQ2 = 79 * MiB;
constexpr size_t WS_XB2 = WS_PROJ + 600 * MiB;
constexpr size_t WS_U = WS_PROJ, WS_GACT = WS_PROJ + (size_t)TH * UPN * 2;
static_assert(WS_HB + (size_t)T * DM * 2 <= WS_PROJ && WS_PROJ + (size_t)T * PLD * 2 <= WS_ODN && WS_ODN + (size_t)T * 512 * 2 <= WS_END, "ws map");
static_assert(WS_GACT + (size_t)TH * FFH * 2 <= WS_ODN, "ffn map");

constexpr int LDS_BYTES = 147456;

typedef float f32x2_t __attribute__((ext_vector_type(2)));
typedef __bf16 bf16x2_t __attribute__((ext_vector_type(2)));
__device__ __forceinline__ unsigned pk2(float lo, float hi) { const f32x2_t v = {lo, hi}; const bf16x2_t b = __builtin_convertvector(v, bf16x2_t); return __builtin_bit_cast(unsigned, b); }
__device__ __forceinline__ unsigned f2bf(float f) { return pk2(f, 0.f) & 0xffffu; }
__device__ __forceinline__ float bflo(unsigned u) { return __builtin_bit_cast(float, u << 16); }
__device__ __forceinline__ float bfhi(unsigned u) { return __builtin_bit_cast(float, u & 0xffff0000u); }
__device__ __forceinline__ float bf1(bf16_t h) { return __builtin_bit_cast(float, (unsigned)h << 16); }
__device__ __forceinline__ float sigmoidf_(float x) { return __builtin_amdgcn_rcpf(1.f + __expf(-x)); }
__device__ __forceinline__ float siluf_(float x) { return x * __builtin_amdgcn_rcpf(1.f + __expf(-x)); }
__device__ __forceinline__ float softplusf_(float x) { return fmaxf(x, 0.f) + __logf(1.f + __expf(-fabsf(x))); }
template <int CTRL> __device__ __forceinline__ float dppf(float x) {
    return __builtin_bit_cast(float, __builtin_amdgcn_update_dpp(0, __builtin_bit_cast(int, x), CTRL, 0xF, 0xF, true));
}
__device__ __forceinline__ float reduce8(float x) {
    x += dppf<0xB1>(x); x += dppf<0x4E>(x); x += dppf<0x141>(x); return x;
}
__device__ __forceinline__ float reduce16(float x) {
    x = reduce8(x); x += dppf<0x140>(x); return x;
}
__device__ __forceinline__ float wave_sum(float x) {
    x = reduce16(x);
    const int xi = __builtin_bit_cast(int, x);
    return (__builtin_bit_cast(float, __builtin_amdgcn_readlane(xi, 0)) + __builtin_bit_cast(float, __builtin_amdgcn_readlane(xi, 16)))
         + (__builtin_bit_cast(float, __builtin_amdgcn_readlane(xi, 32)) + __builtin_bit_cast(float, __builtin_amdgcn_readlane(xi, 48)));
}
#define LDS_WAIT() asm volatile("s_waitcnt lgkmcnt(0)" ::: "memory")
#define LDS_BARRIER() asm volatile("s_waitcnt lgkmcnt(0)\n\ts_barrier" ::: "memory")

namespace pg8 {
constexpr int BM = 256, BK = 64, HALF = 128, HTB = HALF * BK * 2, NXCD = 8, WGM = 8;
__host__ __device__ __forceinline__ int lds_byte(int r, int c) { const int st = (r >> 4) * 2 + (c >> 5), rr = r & 15, cc = c & 31, ob = rr * 64 + cc * 2; return st * 1024 + (ob ^ (((ob >> 9) & 1) << 5)); }
__host__ __device__ __forceinline__ void stage_rc(int b, int& R, int& C) { const int st = b / 1024, sb = b % 1024, swz = sb ^ (((sb >> 9) & 1) << 5); R = (st >> 1) * 16 + swz / 64; C = (st & 1) * 32 + (swz % 64) / 2; }
__host__ __device__ __forceinline__ int perm32(int rho) { const int n = rho >> 4, i = rho & 15; return 8 * (i >> 2) + 4 * n + (i & 3); }

struct Unit { int pm, pn, z; };
struct Gemm { const bf16_t* A; const bf16_t* Bt; int lda; int K; size_t zB; size_t zA1, zA2;
    __device__ __forceinline__ size_t zA(int z) const { return z == 0 ? (size_t)0 : (z == 1 ? zA1 : zA2); } };

struct StaticOrder {
    int nM, nN, nwg, G, c;
    __device__ void init(int M, int N, int G_, int c_) { nM = M / BM; nN = N / BM; nwg = nM * nN; G = G_; c = c_; }
    __device__ __forceinline__ bool next(int i, Unit& u) const {
        const long L = (long)i * G + c; if (L >= nwg) return false;
        int wgid = (int)L; { const int q = nwg / NXCD, r = nwg % NXCD, xcd = wgid % NXCD, off = wgid / NXCD; wgid = (xcd < r ? xcd * (q + 1) : r * (q + 1) + (xcd - r) * q) + off; }
        const int nig = WGM * nN, gid = wgid / nig, fm = gid * WGM, gsz = (nM - fm) < WGM ? (nM - fm) : WGM;
        u.pm = fm + ((wgid % nig) % gsz); u.pn = (wgid % nig) / gsz; u.z = 0; return true;
    }
};
struct BranchOrder {
    StaticOrder base;
    __device__ __forceinline__ bool next(int i, Unit& u) const { if (!base.next(i / 3, u)) return false; u.z = i % 3; return true; }
};

typedef f32x4 Acc[2][2][4][2];

struct EpiBf16 {
    bf16_t* O; int ldc; const float* ssq;
    __device__ __forceinline__ bool reset(const Unit&) const { return true; }
    __device__ __forceinline__ void operator()(Acc& acc, const Unit& u, int wr, int wc, int fr, int fq) const {
        const int row0 = u.pm * BM + wr * 64 + fr, col0 = u.pn * BM + wc * 32 + 8 * fq;
        float rsv[2][4];
#pragma unroll
        for (int ai = 0; ai < 2; ++ai)
#pragma unroll
            for (int m = 0; m < 4; ++m) rsv[ai][m] = ssq[row0 + ai * HALF + m * 16];
#pragma unroll
        for (int ai = 0; ai < 2; ++ai)
#pragma unroll
            for (int m = 0; m < 4; ++m) { bf16_t* rowp = O + (size_t)(row0 + ai * HALF + m * 16) * ldc + col0; const float rs = rsqrtf(rsv[ai][m] * (1.f / DM) + EPS);
#pragma unroll
                for (int bj = 0; bj < 2; ++bj) { const f32x4 v0 = acc[ai][bj][m][0] * rs, v1 = acc[ai][bj][m][1] * rs;
                    u32x4 w; w.x = pk2(v0[0], v0[1]); w.y = pk2(v0[2], v0[3]); w.z = pk2(v1[0], v1[1]); w.w = pk2(v1[2], v1[3]);
                    *(u32x4*)(rowp + bj * HALF) = w; } }
    }
};
struct EpiProj {
    bf16_t* O; int ldc; bf16_t* H; const float* ssq;
    __device__ __forceinline__ bool reset(const Unit&) const { return true; }
    __device__ __forceinline__ void operator()(Acc& acc, const Unit& u, int wr, int wc, int fr, int fq) const {
        const int row0 = u.pm * BM + wr * 64 + fr, col0 = u.pn * BM + wc * 32 + 8 * fq;
        const bool halo = (u.pn >= 14) && (u.pn <= 20) && (fr >= 13);
        float rsv[2][4];
#pragma unroll
        for (int ai = 0; ai < 2; ++ai)
#pragma unroll
            for (int m = 0; m < 4; ++m) rsv[ai][m] = ssq[row0 + ai * HALF + m * 16];
#pragma unroll
        for (int ai = 0; ai < 2; ++ai)
#pragma unroll
            for (int m = 0; m < 4; ++m) { const int row = row0 + ai * HALF + m * 16; bf16_t* rowp = O + (size_t)row * ldc + col0; const float rs = rsqrtf(rsv[ai][m] * (1.f / DM) + EPS);
#pragma unroll
                for (int bj = 0; bj < 2; ++bj) { const f32x4 v0 = acc[ai][bj][m][0] * rs, v1 = acc[ai][bj][m][1] * rs;
                    u32x4 w; w.x = pk2(v0[0], v0[1]); w.y = pk2(v0[2], v0[3]); w.z = pk2(v1[0], v1[1]); w.w = pk2(v1[2], v1[3]);
                    *(u32x4*)(rowp + bj * HALF) = w;
                    if (m == 3 && halo) *(u32x4*)(H + ((size_t)(row >> 6) * 3 + (fr - 13)) * HALO_LD + (col0 + bj * HALF - HALO_C0)) = w; } }
    }
};
struct EpiGate {
    bf16_t* P; const float* bias; const float* ssq;
    __device__ __forceinline__ bool reset(const Unit&) const { return true; }
    __device__ __forceinline__ void operator()(Acc& acc, const Unit& u, int wr, int wc, int fr, int fq) const {
        const int row0 = u.pm * BM + wr * 64 + fr, colt = u.pn * BM, n = colt >> 10;
        const int gb = (n == 0 ? C_GATE0 : (n == 1 ? C_GATE1 : C_GATE2)) + (colt & 1023);
        const int col0 = gb + wc * 32 + 8 * fq, bcol0 = colt + wc * 32 + 8 * fq;
        f32x4 bv[2][2];
#pragma unroll
        for (int bj = 0; bj < 2; ++bj)
#pragma unroll
            for (int nn = 0; nn < 2; ++nn) bv[bj][nn] = *(const f32x4*)(bias + bcol0 + bj * HALF + 4 * nn);
        float rsv[2][4];
#pragma unroll
        for (int ai = 0; ai < 2; ++ai)
#pragma unroll
            for (int m = 0; m < 4; ++m) rsv[ai][m] = ssq[row0 + ai * HALF + m * 16];
#pragma unroll
        for (int ai = 0; ai < 2; ++ai)
#pragma unroll
            for (int m = 0; m < 4; ++m) { bf16_t* rowp = P + (size_t)(row0 + ai * HALF + m * 16) * PLD + col0; const float rs = rsqrtf(rsv[ai][m] * (1.f / DM) + EPS);
#pragma unroll
                for (int bj = 0; bj < 2; ++bj) { f32x4 v0 = acc[ai][bj][m][0] * rs + bv[bj][0], v1 = acc[ai][bj][m][1] * rs + bv[bj][1];
#pragma unroll
                    for (int e = 0; e < 4; ++e) { v0[e] = fmaxf(sigmoidf_(v0[e]), 1e-30f); v1[e] = fmaxf(sigmoidf_(v1[e]), 1e-30f); }
                    u32x4 w; w.x = pk2(v0[0], v0[1]); w.y = pk2(v0[2], v0[3]); w.z = pk2(v1[0], v1[1]); w.w = pk2(v1[2], v1[3]);
                    *(u32x4*)(rowp + bj * HALF) = w; } }
    }
};
struct EpiBranch {
    const bf16_t* P; bf16_t* O;
    __device__ __forceinline__ bool reset(const Unit& u) const { return u.z == 2; }
    __device__ __forceinline__ void operator()(Acc& acc, const Unit& u, int wr, int wc, int fr, int fq) const {
        const int row0 = u.pm * BM + wr * 64 + fr, col0 = u.pn * BM + wc * 32 + 8 * fq;
        const int gz = (u.z == 0 ? C_GATE0 : (u.z == 1 ? C_GATE1 : C_GATE2)), gn = (u.z == 0 ? C_GATE1 : C_GATE2);
#pragma unroll
        for (int ai = 0; ai < 2; ++ai) {
            u32x4 ga[4][2], gb[4][2];
#pragma unroll
            for (int m = 0; m < 4; ++m) { const bf16_t* prow = P + (size_t)(row0 + ai * HALF + m * 16) * PLD + col0;
#pragma unroll
                for (int bj = 0; bj < 2; ++bj) { ga[m][bj] = *(const u32x4*)(prow + gz + bj * HALF); gb[m][bj] = (u.z < 2) ? *(const u32x4*)(prow + gn + bj * HALF) : ga[m][bj]; } }
#pragma unroll
            for (int m = 0; m < 4; ++m) { const int row = row0 + ai * HALF + m * 16;
#pragma unroll
                for (int bj = 0; bj < 2; ++bj) {
                    const u32x4 a = ga[m][bj], b = gb[m][bj];
                    float s[8] = {bflo(a.x), bfhi(a.x), bflo(a.y), bfhi(a.y), bflo(a.z), bfhi(a.z), bflo(a.w), bfhi(a.w)};
                    if (u.z < 2) { const float d[8] = {bflo(b.x), bfhi(b.x), bflo(b.y), bfhi(b.y), bflo(b.z), bfhi(b.z), bflo(b.w), bfhi(b.w)};
#pragma unroll
                        for (int e = 0; e < 8; ++e) s[e] = s[e] * __builtin_amdgcn_rcpf(d[e]); }
                    f32x4 v0 = acc[ai][bj][m][0], v1 = acc[ai][bj][m][1];
#pragma unroll
                    for (int e = 0; e < 4; ++e) { v0[e] *= s[e]; v1[e] *= s[4 + e]; }
                    acc[ai][bj][m][0] = v0; acc[ai][bj][m][1] = v1;
                    if (u.z == 2) { u32x4 w; w.x = pk2(v0[0], v0[1]); w.y = pk2(v0[2], v0[3]); w.z = pk2(v1[0], v1[1]); w.w = pk2(v1[2], v1[3]);
                        *(u32x4*)(O + (size_t)row * DM + col0 + bj * HALF) = w; }
                } }
        }
    }
};
struct EpiResid {
    const float* Xi; float* Xo; bf16_t* XB; float* ssq;
    __device__ __forceinline__ bool reset(const Unit&) const { return true; }
    __device__ __forceinline__ void operator()(Acc& acc, const Unit& u, int wr, int wc, int fr, int fq) const {
        const int row0 = u.pm * BM + wr * 64 + fr, col0 = u.pn * BM + wc * 32 + 8 * fq;
#pragma unroll
        for (int ai = 0; ai < 2; ++ai) {
            f32x4 xa[4][2], xb[4][2];
#pragma unroll
            for (int m = 0; m < 4; ++m) { const size_t off = (size_t)(row0 + ai * HALF + m * 16) * DM + col0;
#pragma unroll
                for (int bj = 0; bj < 2; ++bj) { xa[m][bj] = *(const f32x4*)(Xi + off + bj * HALF); xb[m][bj] = *(const f32x4*)(Xi + off + bj * HALF + 4); } }
#pragma unroll
            for (int m = 0; m < 4; ++m) { const size_t off = (size_t)(row0 + ai * HALF + m * 16) * DM + col0; float p = 0.f;
#pragma unroll
                for (int bj = 0; bj < 2; ++bj) {
                    const f32x4 x0 = xa[m][bj] + acc[ai][bj][m][0], x1 = xb[m][bj] + acc[ai][bj][m][1];
                    *(f32x4*)(Xo + off + bj * HALF) = x0; *(f32x4*)(Xo + off + bj * HALF + 4) = x1;
                    if (XB) { u32x4 w; w.x = pk2(x0[0], x0[1]); w.y = pk2(x0[2], x0[3]); w.z = pk2(x1[0], x1[1]); w.w = pk2(x1[2], x1[3]); *(u32x4*)(XB + off + bj * HALF) = w;
                        p += (x0[0] * x0[0] + x0[1] * x0[1]) + (x0[2] * x0[2] + x0[3] * x0[3]) + (x1[0] * x1[0] + x1[1] * x1[1]) + (x1[2] * x1[2] + x1[3] * x1[3]); } }
                if (XB) { p += __shfl_xor(p, 16); p += __shfl_xor(p, 32); if (fq == 0) atomicAdd(ssq + row0 + ai * HALF + m * 16, p); } }
        }
    }
};

template <class Epi, class Sched>
__device__ __forceinline__ void gemm_phase(LAS unsigned char* lds, const Gemm g, const Sched& S, const Epi& E) {
    int tid = threadIdx.x; asm volatile("" : "+v"(tid));
    const int wid = __builtin_amdgcn_readfirstlane(tid >> 6), lane = tid & 63, wr = wid >> 2, wc = wid & 3, fr = lane & 15, fq = lane >> 4;
    const int K = g.K, nt = K / BK, lda = g.lda;
    unsigned voffA[2], voffB[2];
#pragma unroll
    for (int i = 0; i < 2; ++i) { int R, C; stage_rc(tid * 16 + i * 8192, R, C); const int Rb = (R & ~31) + perm32(R & 31);
        voffA[i] = (unsigned)(R * lda + C) * 2u; voffB[i] = (unsigned)(Rb * K + C) * 2u; }
    const size_t kstep = (size_t)(BK * 2);
    const size_t hstepA = (size_t)HALF * lda * 2, hstepB = (size_t)HALF * K * 2;
    const size_t tstepA = 2 * hstepA, tstepB = 2 * hstepB;
    const unsigned ldsw = (unsigned)wid * 1024u;
    const int aoff = lds_byte(wr * 64 + fr, fq * 8), boff = lds_byte(wc * 32 + fr, fq * 8);
#define PG8_SA(b, h) (((b) * 2 + (h)) * HTB)
#define PG8_SB(b, h) ((4 + (b) * 2 + (h)) * HTB)
#define PG8_STAGE(bufoff, gbase, voff) do { _Pragma("unroll") for (int _i = 0; _i < 2; ++_i) \
        __builtin_amdgcn_global_load_lds((const unsigned*)((const char*)(gbase) + (voff)[_i]), (LAS unsigned*)(lds + (bufoff) + ldsw + _i * 8192), 16, 0, 0); } while (0)
#define PG8_LDA(dst, b, h) do { _Pragma("unroll") for (int m = 0; m < 4; ++m) _Pragma("unroll") for (int k = 0; k < 2; ++k) dst[m][k] = *(const LAS bf16x8*)(lds + PG8_SA(b, h) + aoff + m * 2048 + k * 1024); } while (0)
#define PG8_LDB(dst, b, h) do { _Pragma("unroll") for (int n = 0; n < 2; ++n) _Pragma("unroll") for (int k = 0; k < 2; ++k) dst[n][k] = *(const LAS bf16x8*)(lds + PG8_SB(b, h) + boff + n * 2048 + k * 1024); } while (0)
#define PG8_MMA(ai, bj, At, Bt) do { __builtin_amdgcn_s_setprio(1); _Pragma("unroll") for (int m = 0; m < 4; ++m) _Pragma("unroll") for (int n = 0; n < 2; ++n) _Pragma("unroll") for (int k = 0; k < 2; ++k) \
        acc[ai][bj][m][n] = __builtin_amdgcn_mfma_f32_16x16x32_bf16(Bt[n][k], At[m][k], acc[ai][bj][m][n], 0, 0, 0); __builtin_amdgcn_s_setprio(0); } while (0)
#define PG8_WAIT_V(n) asm volatile("s_waitcnt vmcnt(" #n ")" ::: "memory")
#define PG8_WAIT_L(n) asm volatile("s_waitcnt lgkmcnt(" #n ")" ::: "memory")
#define PG8_BAR __builtin_amdgcn_s_barrier()
#define PG8_SCHED __builtin_amdgcn_sched_barrier(0)
#define PG8_ZERO() do { _Pragma("unroll") for (int a = 0; a < 2; ++a) _Pragma("unroll") for (int b = 0; b < 2; ++b) _Pragma("unroll") for (int m = 0; m < 4; ++m) _Pragma("unroll") for (int n = 0; n < 2; ++n) acc[a][b][m][n] = (f32x4){0.f, 0.f, 0.f, 0.f}; } while (0)
    Unit cur, nxt; int ui = 0;
    if (!S.next(0, cur)) return;
    Acc acc;
    PG8_ZERO();
    bf16x8 At[4][2], B0[2][2], B1[2][2];
    const char* cA = (const char*)g.A + (size_t)cur.pm * tstepA + g.zA(cur.z); const char* cB = (const char*)g.Bt + (size_t)cur.pn * tstepB + (size_t)cur.z * g.zB;
    PG8_STAGE(PG8_SB(0, 0), cB, voffB); PG8_STAGE(PG8_SB(0, 1), cB + hstepB, voffB); PG8_STAGE(PG8_SA(0, 0), cA, voffA); PG8_STAGE(PG8_SA(0, 1), cA + hstepA, voffA);
    if (wr == 1) PG8_BAR;
    PG8_WAIT_V(2); PG8_BAR;
    PG8_STAGE(PG8_SB(1, 0), cB + kstep, voffB); PG8_STAGE(PG8_SA(1, 0), cA + kstep, voffA); PG8_STAGE(PG8_SB(1, 1), cB + hstepB + kstep, voffB);
    PG8_WAIT_V(6); PG8_BAR;
    for (;;) {
        const bool has_next = S.next(ui + 1, nxt);
        const char* nA = has_next ? (const char*)g.A + (size_t)nxt.pm * tstepA + g.zA(nxt.z) : cA;
        const char* nB = has_next ? (const char*)g.Bt + (size_t)nxt.pn * tstepB + (size_t)nxt.z * g.zB : cB;
        for (int t = 0; t < nt; t += 2) {
            const bool last = (t == nt - 2);
            const char* a1 = cA + (size_t)(t + 1) * kstep;
            const char* a2 = last ? nA : cA + (size_t)(t + 2) * kstep; const char* b2 = last ? nB : cB + (size_t)(t + 2) * kstep;
            const char* a3 = a2 + kstep; const char* b3 = b2 + kstep;
            PG8_LDB(B0, 0, 0); PG8_LDB(B1, 0, 1); PG8_SCHED; PG8_LDA(At, 0, 0); PG8_STAGE(PG8_SA(1, 1), a1 + hstepA, voffA);
            PG8_WAIT_V(8); PG8_WAIT_L(0); PG8_BAR; PG8_MMA(0, 0, At, B0); PG8_MMA(0, 1, At, B1); PG8_BAR; PG8_SCHED;
            PG8_LDA(At, 0, 1); PG8_STAGE(PG8_SB(0, 0), b2, voffB); PG8_STAGE(PG8_SB(0, 1), b2 + hstepB, voffB); PG8_STAGE(PG8_SA(0, 0), a2, voffA);
            PG8_WAIT_V(8); PG8_WAIT_L(0); PG8_BAR; PG8_MMA(1, 0, At, B0); PG8_MMA(1, 1, At, B1); PG8_BAR; PG8_SCHED;
            PG8_LDB(B0, 1, 0); PG8_LDB(B1, 1, 1); PG8_SCHED; PG8_LDA(At, 1, 0); PG8_STAGE(PG8_SA(0, 1), a2 + hstepA, voffA);
            PG8_WAIT_V(8); PG8_WAIT_L(0); PG8_BAR; PG8_MMA(0, 0, At, B0); PG8_MMA(0, 1, At, B1); PG8_BAR; PG8_SCHED;
            PG8_LDA(At, 1, 1); PG8_STAGE(PG8_SB(1, 0), b3, voffB); PG8_STAGE(PG8_SB(1, 1), b3 + hstepB, voffB); PG8_STAGE(PG8_SA(1, 0), a3, voffA);
            PG8_WAIT_V(8); PG8_WAIT_L(0); PG8_BAR; PG8_MMA(1, 0, At, B0); PG8_MMA(1, 1, At, B1); PG8_BAR; PG8_SCHED;
        }
        if (wr == 0) PG8_BAR;
        E(acc, cur, wr, wc, fr, fq);
        if (!has_next) break;
        if (E.reset(cur)) PG8_ZERO();
        cur = nxt; cA = nA; cB = nB; ++ui;
        if (wr == 1) PG8_BAR;
    }
    PG8_WAIT_V(0);
    PG8_BAR;
#undef PG8_SA
#undef PG8_SB
#undef PG8_STAGE
#undef PG8_LDA
#undef PG8_LDB
#undef PG8_MMA
#undef PG8_WAIT_V
#undef PG8_WAIT_L
#undef PG8_BAR
#undef PG8_SCHED
#undef PG8_ZERO
}
}

struct Args { const float* in[21]; float* out; unsigned char* ws; };

template <class RowMap>
__device__ __forceinline__ void transpose_weight(const float* W, int K, int N, const RowMap rm, LAS float* scr, int gw, int NGW, int lane, const float* gk = nullptr) {
    const int nblk = (N + 31) / 32, nitems = (K / 64) * nblk;
    for (int item = gw; item < nitems; item += NGW) {
        const int kb = item / nblk, nb = item % nblk, k0 = 64 * kb, n0 = 32 * nb;
        const int cn = n0 + (lane & 31);
#pragma unroll
        for (int i = 0; i < 32; ++i) { const int kk = 2 * i + (lane >> 5); scr[kk * 33 + (lane & 31)] = (cn < N) ? W[(size_t)(k0 + kk) * N + cn] * (gk ? gk[k0 + kk] : 1.f) : 0.f; }
        LDS_WAIT(); asm volatile("" ::: "memory");
        const int c = lane & 7;
#pragma unroll
        for (int j = 0; j < 4; ++j) { const int n = (lane >> 3) + 8 * j; const LAS float* s = scr + (8 * c) * 33 + n;
            u32x4 o; o.x = pk2(s[0 * 33], s[1 * 33]); o.y = pk2(s[2 * 33], s[3 * 33]); o.z = pk2(s[4 * 33], s[5 * 33]); o.w = pk2(s[6 * 33], s[7 * 33]);
            if (n0 + n < N) { bf16_t* dst = rm(n0 + n); *(u32x4*)(dst + k0 + 8 * c) = o; } }
        LDS_WAIT(); asm volatile("" ::: "memory");
    }
}
struct RmPlain { bf16_t* base; int K; __device__ __forceinline__ bf16_t* operator()(int n) const { return base + (size_t)n * K; } };
struct RmWin { bf16_t* win; bf16_t* wg; __device__ __forceinline__ bf16_t* operator()(int n) const { return n < NMIXCOL ? win + (size_t)n * DM : wg + (size_t)(n - NMIXCOL) * DM; } };
struct RmUp { bf16_t* base;
    __device__ __forceinline__ bf16_t* operator()(int n) const { const int isb = n >= FFH, j = isb ? n - FFH : n; return base + (size_t)(256 * (j >> 7) + (j & 127) + 128 * isb) * DM; } };

__device__ __forceinline__ void norm_rows_bf16(const float* X, const float* g, bf16_t* O, int gw, int NGW, int lane) {
    f32x4 gv[4];
#pragma unroll
    for (int j = 0; j < 4; ++j) gv[j] = *((const f32x4*)g + lane + 64 * j);
    for (int m = gw; m < T; m += NGW) {
        const f32x4* xr = (const f32x4*)(X + (size_t)m * DM) + lane;
        f32x4 v[4]; float s = 0.f;
#pragma unroll
        for (int j = 0; j < 4; ++j) { v[j] = xr[64 * j]; s += (v[j].x * v[j].x + v[j].y * v[j].y) + (v[j].z * v[j].z + v[j].w * v[j].w); }
        const float rstd = rsqrtf(wave_sum(s) * (1.f / DM) + EPS);
        u32x2* o8 = (u32x2*)(O + (size_t)m * DM) + lane;
#pragma unroll
        for (int j = 0; j < 4; ++j) { u32x2 w; w.x = pk2(v[j].x * rstd * gv[j].x, v[j].y * rstd * gv[j].y); w.y = pk2(v[j].z * rstd * gv[j].z, v[j].w * rstd * gv[j].w); o8[64 * j] = w; }
    }
}
__device__ __forceinline__ void conv_rows_bf16(const float* X, bf16_t* O, float* ssq, int gw, int NGW, int lane) {
    for (int m0 = 2 * gw; m0 < T; m0 += 2 * NGW) {
        f32x4 v[2][4];
#pragma unroll
        for (int k = 0; k < 2; ++k) { const f32x4* xr = (const f32x4*)(X + (size_t)(m0 + k) * DM) + lane;
#pragma unroll
            for (int j = 0; j < 4; ++j) v[k][j] = xr[64 * j]; }
#pragma unroll
        for (int k = 0; k < 2; ++k) { float s = 0.f;
            u32x2* o8 = (u32x2*)(O + (size_t)(m0 + k) * DM) + lane;
#pragma unroll
            for (int j = 0; j < 4; ++j) { const f32x4 x = v[k][j]; s += (x.x * x.x + x.y * x.y) + (x.z * x.z + x.w * x.w); u32x2 w; w.x = pk2(x.x, x.y); w.y = pk2(x.z, x.w); o8[64 * j] = w; }
            if (ssq) { s = wave_sum(s); if (lane == 0) ssq[m0 + k] = s; } }
    }
}
__device__ __forceinline__ void norm_rows_f32_inplace(float* X, const float* g, int gw, int NGW, int lane) {
    f32x4 gv[4];
#pragma unroll
    for (int j = 0; j < 4; ++j) gv[j] = *((const f32x4*)g + lane + 64 * j);
    for (int m0 = 2 * gw; m0 < T; m0 += 2 * NGW) {
        f32x4 v[2][4];
#pragma unroll
        for (int k = 0; k < 2; ++k) { const f32x4* xr = (const f32x4*)(X + (size_t)(m0 + k) * DM) + lane;
#pragma unroll
            for (int j = 0; j < 4; ++j) v[k][j] = xr[64 * j]; }
#pragma unroll
        for (int k = 0; k < 2; ++k) { float s = 0.f;
#pragma unroll
            for (int j = 0; j < 4; ++j) { const f32x4 x = v[k][j]; s += (x.x * x.x + x.y * x.y) + (x.z * x.z + x.w * x.w); }
            const float rstd = rsqrtf(wave_sum(s) * (1.f / DM) + EPS);
            f32x4* xw = (f32x4*)(X + (size_t)(m0 + k) * DM) + lane;
#pragma unroll
            for (int j = 0; j < 4; ++j) xw[64 * j] = v[k][j] * rstd * gv[j]; }
    }
}

__device__ __forceinline__ void hnorm_phase(bf16_t* proj, const bf16_t* odn, const float* g0, const float* g1, const float* g2, int gw, int NGW, int lane) {
    for (int it0 = 4 * gw; it0 < 3 * T; it0 += 4 * NGW) {
        u32x4 a[4], zz[4]; bf16_t* dst[4]; const float* gg[4];
#pragma unroll
        for (int k = 0; k < 4; ++k) {
            const int it = it0 + k, n = it % 3, t = it / 3;
            bf16_t* prow = proj + (size_t)t * PLD;
            const bf16_t* src = (n == 0) ? prow + C_HGI : (n == 1 ? prow + C_GLV : odn + (size_t)t * 512);
            const bf16_t* zsrc = prow + (n == 0 ? C_HGG : (n == 1 ? C_GLG : C_DNZ));
            dst[k] = prow + (n == 0 ? C_HGI : (n == 1 ? C_GLV : C_DNV));
            gg[k] = (n == 0 ? g0 : (n == 1 ? g1 : g2)) + (lane & 15) * 8;
            a[k] = *(const u32x4*)(src + lane * 8); zz[k] = *(const u32x4*)(zsrc + lane * 8);
        }
#pragma unroll
        for (int k = 0; k < 4; ++k) {
            float o[8] = {bflo(a[k].x), bfhi(a[k].x), bflo(a[k].y), bfhi(a[k].y), bflo(a[k].z), bfhi(a[k].z), bflo(a[k].w), bfhi(a[k].w)};
            const float z[8] = {bflo(zz[k].x), bfhi(zz[k].x), bflo(zz[k].y), bfhi(zz[k].y), bflo(zz[k].z), bfhi(zz[k].z), bflo(zz[k].w), bfhi(zz[k].w)};
            float s = 0.f;
#pragma unroll
            for (int e = 0; e < 8; ++e) s += o[e] * o[e];
            s = reduce16(s);
            const float rstd = rsqrtf(s * (1.f / 128.f) + EPS);
            const f32x4 ga = *(const f32x4*)gg[k], gb = *(const f32x4*)(gg[k] + 4);
            const float gv[8] = {ga.x, ga.y, ga.z, ga.w, gb.x, gb.y, gb.z, gb.w};
#pragma unroll
            for (int e = 0; e < 8; ++e) o[e] = o[e] * rstd * gv[e] * siluf_(z[e]);
            u32x4 w; w.x = pk2(o[0], o[1]); w.y = pk2(o[2], o[3]); w.z = pk2(o[4], o[5]); w.w = pk2(o[6], o[7]);
            *(u32x4*)(dst[k] + lane * 8) = w;
        }
    }
}

__device__ __forceinline__ void convgate_phase(const bf16_t* U, bf16_t* G, const float* cw, const float* cb, int gtid, int NT) {
    constexpr int RUN = 8, NJ = FFH / 8, NITEM = (TH / RUN) * NJ;
    for (int it = gtid; it < NITEM; it += NT) {
        const int jg = it % NJ, tr = it / NJ, j = jg * 8, t0 = tr * RUN;
        const int ca = 256 * (j >> 7) + (j & 127);
        const bool first = (t0 & (SEQ - 1)) == 0;
        const bf16_t* up = U + (size_t)t0 * UPN + ca;
        u32x4 ra[10], rb[10];
        if (!first) { ra[0] = *(const u32x4*)(up - 2 * (size_t)UPN); rb[0] = *(const u32x4*)(up - 2 * (size_t)UPN + 128); ra[1] = *(const u32x4*)(up - (size_t)UPN); rb[1] = *(const u32x4*)(up - (size_t)UPN + 128); }
        else { ra[0] = (u32x4){0, 0, 0, 0}; rb[0] = ra[0]; ra[1] = ra[0]; rb[1] = ra[0]; }
#pragma unroll
        for (int r = 0; r < 8; ++r) { ra[2 + r] = *(const u32x4*)(up + (size_t)r * UPN); rb[2 + r] = *(const u32x4*)(up + (size_t)r * UPN + 128); }
        float wa[3][8], wb[3][8], ba[8], bb[8];
#pragma unroll
        for (int k = 0; k < 3; ++k)
#pragma unroll
            for (int e = 0; e < 8; ++e) { wa[k][e] = cw[(size_t)k * UPN + j + e]; wb[k][e] = cw[(size_t)k * UPN + FFH + j + e]; }
#pragma unroll
        for (int e = 0; e < 8; ++e) { ba[e] = cb[j + e]; bb[e] = cb[FFH + j + e]; }
#pragma unroll
        for (int r = 0; r < 8; ++r) {
            const unsigned au[3][4] = {{ra[r].x, ra[r].y, ra[r].z, ra[r].w}, {ra[r + 1].x, ra[r + 1].y, ra[r + 1].z, ra[r + 1].w}, {ra[r + 2].x, ra[r + 2].y, ra[r + 2].z, ra[r + 2].w}};
            const unsigned bu[3][4] = {{rb[r].x, rb[r].y, rb[r].z, rb[r].w}, {rb[r + 1].x, rb[r + 1].y, rb[r + 1].z, rb[r + 1].w}, {rb[r + 2].x, rb[r + 2].y, rb[r + 2].z, rb[r + 2].w}};
            float o[8];
#pragma unroll
            for (int e = 0; e < 8; ++e) {
                float xa = ba[e], xb = bb[e];
#pragma unroll
                for (int k = 0; k < 3; ++k) { const float va = (e & 1) ? bfhi(au[k][e >> 1]) : bflo(au[k][e >> 1]); const float vb = (e & 1) ? bfhi(bu[k][e >> 1]) : bflo(bu[k][e >> 1]);
                    xa += wa[k][e] * va; xb += wb[k][e] * vb; }
                o[e] = siluf_(xa) * xb;
            }
            u32x4 w; w.x = pk2(o[0], o[1]); w.y = pk2(o[2], o[3]); w.z = pk2(o[4], o[5]); w.w = pk2(o[6], o[7]);
            *(u32x4*)(G + (size_t)(t0 + r) * FFH + j) = w;
        }
    }
}

constexpr int TB = 16;
constexpr int MIX_BUF_FLOATS = 3 * TB * 160 + TB * 64 + 2 * TB;
struct MixArgs { bf16_t* proj; bf16_t* odn; const bf16_t* halo; float* dec; const float* lbsrc; int layer; const float* w2; const float* gkb; const float* convw; const float* Alog; const float* dtb; };

template <int MIX>
__device__ __forceinline__ void mixer_chain(LAS unsigned char* lds, const MixArgs& A, int b, int h, int half) {
    constexpr int DK = (MIX == 1) ? 64 : 128, DS = DK / 8, DSP = (DS == 16) ? 20 : 8, ROW = 8 * DSP;
    int tid = threadIdx.x; asm volatile("" : "+v"(tid));
    const int lane = tid & 63, w = __builtin_amdgcn_readfirstlane(tid >> 6), ds = lane & 7, cgp = lane >> 3;
    LAS float* L = (LAS float*)lds;
    const size_t tbase = (size_t)b * SEQ;
    bf16_t* proj = A.proj;
    float c0 = 0.f, c1 = 0.f;
    float w2c[16]; float gb = 0.f;
    float wq[4][2], wk[4][2], wv[4][2]; float Aexp = 0.f, dtb = 0.f;
    if (MIX == 0) {
        if (A.layer == 1) { const float* p = A.lbsrc + h * 128 + 2 * lane; c0 = 1.f / (1.f + __expf(p[0] - p[512])); c1 = 1.f / (1.f + __expf(p[1] - p[513])); }
    } else if (MIX == 1) {
#pragma unroll
        for (int r = 0; r < 16; ++r) w2c[r] = A.w2[r * 256 + h * 64 + lane];
        gb = A.gkb[h * 64 + lane];
    } else {
#pragma unroll
        for (int j = 0; j < 4; ++j) {
            wq[j][0] = A.convw[j * 1536 + h * 128 + 2 * lane]; wq[j][1] = A.convw[j * 1536 + h * 128 + 2 * lane + 1];
            wk[j][0] = A.convw[j * 1536 + 512 + h * 128 + 2 * lane]; wk[j][1] = A.convw[j * 1536 + 512 + h * 128 + 2 * lane + 1];
            const int vc = 1024 + h * 128 + half * 64 + 2 * (lane & 31);
            wv[j][0] = A.convw[j * 1536 + vc]; wv[j][1] = A.convw[j * 1536 + vc + 1];
        }
        Aexp = __expf(A.Alog[h]); dtb = A.dtb[h];
    }
    unsigned rq[2][4], rk[2][4], rv[2][4], rs[2][2]; u32x4 rl[2][2];
    auto load_block = [&](int blk) {
#pragma unroll
        for (int i = 0; i < 2; ++i) {
            const int tin = blk * TB + 2 * w + i;
            const bf16_t* row = proj + (tbase + tin) * PLD;
            if (MIX == 0) {
                rq[i][0] = *(const unsigned*)(row + C_HGQ + h * 128 + 2 * lane);
                rk[i][0] = *(const unsigned*)(row + C_HGF + h * 128 + 2 * lane);
                rv[i][0] = *(const unsigned*)(row + C_HGI + h * 128 + half * 64 + 2 * (lane & 31));
            } else if (MIX == 1) {
                rq[i][0] = row[C_GLQ + h * 64 + lane]; rk[i][0] = row[C_GLK + h * 64 + lane];
                rv[i][0] = *(const unsigned*)(row + C_GLV + h * 128 + half * 64 + 2 * (lane & 31));
                rl[i][0] = *(const u32x4*)(row + C_GLGK); rl[i][1] = *(const u32x4*)(row + C_GLGK + 8);
            } else {
#pragma unroll
                for (int j = 0; j < 4; ++j) {
                    const int tt = tin - 3 + j;
                    if (tt >= 0) { const bf16_t* r2 = proj + (tbase + tt) * PLD;
                        rq[i][j] = *(const unsigned*)(r2 + C_DNQ + h * 128 + 2 * lane); rk[i][j] = *(const unsigned*)(r2 + C_DNK + h * 128 + 2 * lane);
                        rv[i][j] = *(const unsigned*)(r2 + C_DNV + h * 128 + half * 64 + 2 * (lane & 31)); }
                    else { rq[i][j] = 0u; rk[i][j] = 0u; rv[i][j] = 0u; }
                }
                rs[i][0] = row[C_DNB + h]; rs[i][1] = row[C_DNA + h];
            }
        }
    };
    auto store_block = [&](int buf) {
        LAS float* Q = L + buf * MIX_BUF_FLOATS; LAS float* Kp = Q + TB * 160; LAS float* F = Kp + TB * 160; LAS float* V = F + TB * 160; LAS float* SA = V + TB * 64; LAS float* SB = SA + TB;
#pragma unroll
        for (int i = 0; i < 2; ++i) {
            const int tok = 2 * w + i;
            if (MIX == 0) {
                const int d = 2 * lane, idx = tok * ROW + (d >> 4) * DSP + (d & 15);
                const float q0 = bflo(rq[i][0]), q1 = bfhi(rq[i][0]), z0 = bflo(rk[i][0]), z1 = bfhi(rk[i][0]);
                const float s0 = sigmoidf_(z0), s1 = sigmoidf_(z1);
                Q[idx] = siluf_(q0) * 0.08838834764831845f; Q[idx + 1] = siluf_(q1) * 0.08838834764831845f;
                F[idx] = c0 + (1.f - c0) * s0; F[idx + 1] = c1 + (1.f - c1) * s1;
                Kp[idx] = (1.f - c0) * (1.f - s0); Kp[idx + 1] = (1.f - c1) * (1.f - s1);
                if (lane < 32) { V[tok * 64 + 2 * lane] = bflo(rv[i][0]); V[tok * 64 + 2 * lane + 1] = bfhi(rv[i][0]); }
            } else if (MIX == 1) {
                const int idx = tok * ROW + lane;
                const unsigned lr[8] = {rl[i][0].x, rl[i][0].y, rl[i][0].z, rl[i][0].w, rl[i][1].x, rl[i][1].y, rl[i][1].z, rl[i][1].w};
                float gk = gb;
#pragma unroll
                for (int r = 0; r < 8; ++r) gk += bflo(lr[r]) * w2c[2 * r] + bfhi(lr[r]) * w2c[2 * r + 1];
                const float ls = fminf(gk, 0.f) - __logf(1.f + __expf(-fabsf(gk)));
                Q[idx] = bf1((bf16_t)rq[i][0]) * 0.125f; Kp[idx] = bf1((bf16_t)rk[i][0]); F[idx] = __expf(ls * (1.f / 16.f));
                if (lane < 32) { V[tok * 64 + 2 * lane] = bflo(rv[i][0]); V[tok * 64 + 2 * lane + 1] = bfhi(rv[i][0]); }
            } else {
                const int d = 2 * lane, idx = tok * ROW + (d >> 4) * DSP + (d & 15);
                float q0 = 0.f, q1 = 0.f, k0 = 0.f, k1 = 0.f, v0 = 0.f, v1 = 0.f;
#pragma unroll
                for (int j = 0; j < 4; ++j) { q0 += wq[j][0] * bflo(rq[i][j]); q1 += wq[j][1] * bfhi(rq[i][j]); k0 += wk[j][0] * bflo(rk[i][j]); k1 += wk[j][1] * bfhi(rk[i][j]);
                    v0 += wv[j][0] * bflo(rv[i][j]); v1 += wv[j][1] * bfhi(rv[i][j]); }
                q0 = siluf_(q0); q1 = siluf_(q1); k0 = siluf_(k0); k1 = siluf_(k1); v0 = siluf_(v0); v1 = siluf_(v1);
                const float nq = rsqrtf(wave_sum(q0 * q0 + q1 * q1) + EPS) * 0.08838834764831845f, nk = rsqrtf(wave_sum(k0 * k0 + k1 * k1) + EPS);
                Q[idx] = q0 * nq; Q[idx + 1] = q1 * nq; Kp[idx] = k0 * nk; Kp[idx + 1] = k1 * nk;
                if (lane < 32) { V[tok * 64 + 2 * lane] = v0; V[tok * 64 + 2 * lane + 1] = v1; }
                if (lane == 0) { const float be = sigmoidf_(bf1((bf16_t)rs[i][0])); const float gg = -Aexp * softplusf_(bf1((bf16_t)rs[i][1]) + dtb);
                    SA[tok] = __expf(gg); SB[tok] = be; }
            }
        }
    };
    float S[DS];
#pragma unroll
    for (int i = 0; i < DS; ++i) S[i] = 0.f;
    const int col = half * 64 + w * 8 + cgp;
    bf16_t* obase = (MIX == 0) ? proj + tbase * PLD + C_HGI + h * 128 + col : (MIX == 1 ? proj + tbase * PLD + C_GLV + h * 128 + col : A.odn + tbase * 512 + h * 128 + col);
    const size_t opitch = (MIX == 2) ? 512 : PLD;
    constexpr int NBLK = SEQ / TB;
    load_block(0);
    for (int blk = 0; blk < NBLK; ++blk) {
        const int buf = blk & 1;
        store_block(buf);
        __syncthreads();
        if (blk + 1 < NBLK) load_block(blk + 1);
        const LAS float* Q = L + buf * MIX_BUF_FLOATS; const LAS float* Kp = Q + TB * 160; const LAS float* F = Kp + TB * 160; const LAS float* V = F + TB * 160; const LAS float* SA = V + TB * 64; const LAS float* SB = SA + TB;
#pragma unroll 2
        for (int tok = 0; tok < TB; ++tok) {
            const int o0 = tok * ROW + ds * DSP;
            float qv[DS], kv[DS], fv[DS];
#pragma unroll
            for (int i = 0; i < DS; i += 4) { const f32x4 a = *(const LAS f32x4*)(Q + o0 + i), c = *(const LAS f32x4*)(Kp + o0 + i);
                qv[i] = a.x; qv[i + 1] = a.y; qv[i + 2] = a.z; qv[i + 3] = a.w; kv[i] = c.x; kv[i + 1] = c.y; kv[i + 2] = c.z; kv[i + 3] = c.w; }
            const float v = V[tok * 64 + w * 8 + cgp];
            float po = 0.f;
            if (MIX != 2) {
#pragma unroll
                for (int i = 0; i < DS; i += 4) { const f32x4 a = *(const LAS f32x4*)(F + o0 + i); fv[i] = a.x; fv[i + 1] = a.y; fv[i + 2] = a.z; fv[i + 3] = a.w; }
#pragma unroll
                for (int i = 0; i < DS; ++i) { S[i] = fv[i] * S[i] + kv[i] * v; po += S[i] * qv[i]; }
            } else {
                float pk0 = 0.f, pk1 = 0.f;
#pragma unroll
                for (int i = 0; i < DS; i += 2) { pk0 += kv[i] * S[i]; pk1 += kv[i + 1] * S[i + 1]; }
                const float kS = reduce8(pk0 + pk1);
                const float a = SA[tok], be = SB[tok];
                const float delta = be * (v - a * kS);
#pragma unroll
                for (int i = 0; i < DS; ++i) { S[i] = a * S[i] + kv[i] * delta; po += S[i] * qv[i]; }
            }
            const float o = reduce8(po);
            if (ds == 0) obase[(size_t)(blk * TB + tok) * opitch] = (bf16_t)f2bf(o);
        }
    }
    __syncthreads();
}

constexpr size_t AUX_SLOT = 32 * MiB;
constexpr int NCHUNK = SEQ / 64;
#define MFMA16(a, b, c) __builtin_amdgcn_mfma_f32_16x16x32_bf16((a), (b), (c), 0, 0, 0)
__device__ __forceinline__ bf16x8 ldsfrag(const LAS bf16_t* p) { return *(const LAS bf16x8*)p; }
__device__ __forceinline__ float logsigmoidf_(float x) { return fminf(x, 0.f) - __logf(1.f + __expf(-fabsf(x))); }

template <int MIX> __device__ __forceinline__ void gla_elem(float rq, float rz, float lb, float gk, float& q, float& k, float& f) {
    if (MIX == 0) { const float s = sigmoidf_(rz); q = siluf_(rq) * 0.08838834764831845f; f = lb + (1.f - lb) * s; k = (1.f - lb) * (1.f - s); }
    else { q = rq * 0.125f; k = rz; f = __expf(logsigmoidf_(gk) * (1.f / 16.f)); }
}

template <int MIX>
__device__ __forceinline__ void prep_gla_item(LAS unsigned char* lds, const MixArgs& A, int b, int h, int n, bf16_t* Aout) {
    constexpr int DK = (MIX == 1) ? 64 : 128, DS = DK / 8, DKR = DK + 4, BS = DK + 8;
    int tid = threadIdx.x; asm volatile("" : "+v"(tid));
    const int lane = tid & 63, w = __builtin_amdgcn_readfirstlane(tid >> 6), r = lane & 15, quad = lane >> 4;
    LAS float* F = (LAS float*)lds; LAS float* DT = F + 64 * DKR;
    LAS bf16_t* QPb = (LAS bf16_t*)(DT + 4 * DK); LAS bf16_t* KPb = QPb + 64 * BS; LAS bf16_t* QT = KPb + 64 * BS; LAS bf16_t* KL = QT + 64 * BS; LAS bf16_t* KS = KL + 64 * BS; LAS bf16_t* AO = KS + 48 * BS;
    const bf16_t* prow = A.proj + ((size_t)b * SEQ + (size_t)n * 64) * PLD;
    const int d = tid % DK, blk = tid / DK;
    float kls[16], qlp[16];
    if (blk < 4) {
        float lb = 0.f, gb = 0.f, w2c[16];
        if (MIX == 0) { if (A.layer == 1) { const float* p = A.lbsrc + h * 128 + d; lb = 1.f / (1.f + __expf(p[0] - p[512])); } }
        else {
#pragma unroll
            for (int rr = 0; rr < 16; ++rr) w2c[rr] = A.w2[rr * 256 + h * 64 + d];
            gb = A.gkb[h * 64 + d];
        }
        unsigned short rq_[16], rz_[16];
#pragma unroll
        for (int i = 0; i < 16; ++i) { const bf16_t* row = prow + (size_t)(blk * 16 + i) * PLD;
            if (MIX == 0) { rq_[i] = row[C_HGQ + h * 128 + d]; rz_[i] = row[C_HGF + h * 128 + d]; }
            else { rq_[i] = row[C_GLQ + h * 64 + d]; rz_[i] = row[C_GLK + h * 64 + d]; } }
        float f[16], qp[16], kp[16];
#pragma unroll
        for (int i = 0; i < 16; ++i) {
            float gk = gb;
            if (MIX == 1) { const bf16_t* row = prow + (size_t)(blk * 16 + i) * PLD; const u32x4 l0 = *(const u32x4*)(row + C_GLGK), l1 = *(const u32x4*)(row + C_GLGK + 8);
                const unsigned lr[8] = {l0.x, l0.y, l0.z, l0.w, l1.x, l1.y, l1.z, l1.w};
#pragma unroll
                for (int rr = 0; rr < 8; ++rr) gk += bflo(lr[rr]) * w2c[2 * rr] + bfhi(lr[rr]) * w2c[2 * rr + 1]; }
            gla_elem<MIX>(bf1(rq_[i]), bf1(rz_[i]), lb, gk, qp[i], kp[i], f[i]);
        }
        float lp = 1.f;
#pragma unroll
        for (int i = 0; i < 16; ++i) { const int t = blk * 16 + i; lp *= f[i];
            qlp[i] = qp[i] * lp; F[t * DKR + d] = f[i]; QPb[t * BS + d] = (bf16_t)f2bf(qp[i]); KPb[t * BS + d] = (bf16_t)f2bf(kp[i]); QT[t * BS + d] = (bf16_t)f2bf(qlp[i]); }
        DT[blk * DK + d] = lp;
        float ls = 1.f;
#pragma unroll
        for (int i = 15; i >= 0; --i) { kls[i] = kp[i] * ls; KL[(blk * 16 + i) * BS + d] = (bf16_t)f2bf(kls[i]); ls *= f[i]; }
    }
    for (int i = tid; i < 64 * 64 / 4; i += 512) ((LAS u32x2*)AO)[i] = (u32x2){0u, 0u};
    LDS_BARRIER();
    if (blk < 4) {
        const float d0 = DT[0 * DK + d], d1 = DT[1 * DK + d], d2 = DT[2 * DK + d], d3 = DT[3 * DK + d];
        const float pprev = (blk == 0) ? 1.f : (blk == 1 ? d0 : (blk == 2 ? d0 * d1 : d0 * d1 * d2)), pnext = (blk == 3) ? 1.f : (blk == 2 ? d3 : (blk == 1 ? d2 * d3 : d1 * d2 * d3));
        bf16_t* grow = A.proj + ((size_t)b * SEQ + (size_t)n * 64) * PLD;
        const int cq = (MIX == 0 ? C_HGQ + h * 128 : C_GLQ + h * 64) + d;
#pragma unroll
        for (int i = 0; i < 16; ++i) grow[(size_t)(blk * 16 + i) * PLD + cq] = (bf16_t)f2bf(qlp[i] * pprev);
        bf16_t* kdst = (MIX == 0) ? grow + (size_t)(d >> 1) * PLD + C_HGF + h * 128 + (d & 1) * 64 + blk * 16 : grow + (size_t)d * PLD + C_GLK + h * 64 + blk * 16;
        u32x4 o0, o1;
        o0.x = pk2(kls[0] * pnext, kls[1] * pnext); o0.y = pk2(kls[2] * pnext, kls[3] * pnext); o0.z = pk2(kls[4] * pnext, kls[5] * pnext); o0.w = pk2(kls[6] * pnext, kls[7] * pnext);
        o1.x = pk2(kls[8] * pnext, kls[9] * pnext); o1.y = pk2(kls[10] * pnext, kls[11] * pnext); o1.z = pk2(kls[12] * pnext, kls[13] * pnext); o1.w = pk2(kls[14] * pnext, kls[15] * pnext);
        *(u32x4*)kdst = o0; *(u32x4*)(kdst + 8) = o1;
        if (blk == 0) A.dec[(MIX == 0 ? (size_t)0 : DEC_GLA_OFF / 4) + ((size_t)(b * 4 + h) * NCHUNK + n) * DK + d] = d0 * d1 * d2 * d3;
    }
    if (blk < 2) {
        const float d1 = DT[1 * DK + d], d2 = DT[2 * DK + d];
#pragma unroll
        for (int i = 0; i < 16; ++i) {
            if (blk == 0) { KS[(0 * 16 + i) * BS + d] = (bf16_t)f2bf(kls[i] * d1); KS[(2 * 16 + i) * BS + d] = (bf16_t)f2bf(kls[i] * d1 * d2); }
            else KS[(1 * 16 + i) * BS + d] = (bf16_t)f2bf(kls[i] * d2);
        }
    }
    LDS_BARRIER();
    if (w < 6) {
        const int bi = (w == 0) ? 1 : ((w == 1 || w == 3) ? 2 : 3), bj = (w < 3) ? w : ((w == 3) ? 0 : (w == 4 ? 1 : 0));
        const LAS bf16_t* Kt = (w < 3) ? KL + (16 * bj) * BS : KS + (16 * (w - 3)) * BS;
        f32x4 acc = {0.f, 0.f, 0.f, 0.f};
#pragma unroll
        for (int kk = 0; kk < DK / 32; ++kk) acc = MFMA16(ldsfrag(Kt + r * BS + 32 * kk + quad * 8), ldsfrag(QT + (16 * bi + r) * BS + 32 * kk + quad * 8), acc);
        u32x2 o; o.x = pk2(acc[0], acc[1]); o.y = pk2(acc[2], acc[3]);
        *(LAS u32x2*)(AO + (16 * bi + r) * 64 + 16 * bj + quad * 4) = o;
    }
    {
        const int gi = (w < 4) ? 2 * w : 2 * (w - 4) + 1;
        const int s = 8 * gi + (lane >> 3), ds = lane & 7, tend = (s | 15) + 1;
        float p[DS];
#pragma unroll
        for (int i = 0; i < DS; i += 8) { const bf16x8 kk8 = ldsfrag(KPb + s * BS + ds * DS + i);
#pragma unroll
            for (int e = 0; e < 8; ++e) p[i + e] = bf1((bf16_t)kk8[e]); }
        float fv[DS], qv[DS];
#define MARCH_LOAD(t_) do { _Pragma("unroll") for (int i = 0; i < DS; i += 4) { const f32x4 a = *(const LAS f32x4*)(F + (t_) * DKR + ds * DS + i); fv[i] = a.x; fv[i + 1] = a.y; fv[i + 2] = a.z; fv[i + 3] = a.w; } \
            _Pragma("unroll") for (int i = 0; i < DS; i += 8) { const bf16x8 q8 = ldsfrag(QPb + (t_) * BS + ds * DS + i); _Pragma("unroll") for (int e = 0; e < 8; ++e) qv[i + e] = bf1((bf16_t)q8[e]); } } while (0)
        MARCH_LOAD(8 * gi);
        for (int t = 8 * gi; t < tend; ++t) {
            float fc[DS], qc[DS];
#pragma unroll
            for (int i = 0; i < DS; ++i) { fc[i] = fv[i]; qc[i] = qv[i]; }
            { const int tn = (t + 1 < 64) ? t + 1 : t; MARCH_LOAD(tn); }
            const bool adv = t > s;
            float a0 = 0.f, a1 = 0.f;
#pragma unroll
            for (int i = 0; i < DS; i += 2) { p[i] = adv ? p[i] * fc[i] : p[i]; p[i + 1] = adv ? p[i + 1] * fc[i + 1] : p[i + 1]; a0 += p[i] * qc[i]; a1 += p[i + 1] * qc[i + 1]; }
            const float tot = reduce8(a0 + a1);
            if (ds == 0 && t >= s) AO[t * 64 + s] = (bf16_t)f2bf(tot);
        }
#undef MARCH_LOAD
    }
    LDS_BARRIER();
    *(u32x4*)(Aout + tid * 8) = *(const LAS u32x4*)(AO + tid * 8);
    LDS_BARRIER();
}

struct DnConv { float wq[4][2], wk[4][2]; };
__device__ __forceinline__ void dn_load_conv(DnConv& c, const float* convw, int h, int lane) {
#pragma unroll
    for (int j = 0; j < 4; ++j) { c.wq[j][0] = convw[j * 1536 + h * 128 + 2 * lane]; c.wq[j][1] = convw[j * 1536 + h * 128 + 2 * lane + 1];
        c.wk[j][0] = convw[j * 1536 + 512 + h * 128 + 2 * lane]; c.wk[j][1] = convw[j * 1536 + 512 + h * 128 + 2 * lane + 1]; }
}
struct DnRaw { unsigned q[11], k[11]; };
__device__ __forceinline__ void dn_load_rows(DnRaw& R, const bf16_t* seqrow, const bf16_t* hrow, int cbase, int tin0, int h, int lane) {
#pragma unroll
    for (int i = 0; i < 11; ++i) { const int tt = tin0 - 3 + i;
        if (tt >= cbase) { const bf16_t* r2 = seqrow + (size_t)tt * PLD; R.q[i] = *(const unsigned*)(r2 + C_DNQ + h * 128 + 2 * lane); R.k[i] = *(const unsigned*)(r2 + C_DNK + h * 128 + 2 * lane); }
        else if (hrow) { const bf16_t* r2 = hrow + (size_t)(tt - (cbase - 3)) * HALO_LD - HALO_C0; R.q[i] = *(const unsigned*)(r2 + C_DNQ + h * 128 + 2 * lane); R.k[i] = *(const unsigned*)(r2 + C_DNK + h * 128 + 2 * lane); }
        else { R.q[i] = 0u; R.k[i] = 0u; } }
}
template <int I> __device__ __forceinline__ void dn_qk_token(const DnConv& c, const DnRaw& R, float& q0, float& q1, float& k0, float& k1) {
    q0 = q1 = k0 = k1 = 0.f;
#pragma unroll
    for (int j = 0; j < 4; ++j) { const unsigned uq = R.q[I + j], uk = R.k[I + j];
        q0 += c.wq[j][0] * bflo(uq); q1 += c.wq[j][1] * bfhi(uq); k0 += c.wk[j][0] * bflo(uk); k1 += c.wk[j][1] * bfhi(uk); }
    q0 = siluf_(q0); q1 = siluf_(q1); k0 = siluf_(k0); k1 = siluf_(k1);
    const float nq = __builtin_amdgcn_rsqf(wave_sum(q0 * q0 + q1 * q1) + EPS) * 0.08838834764831845f, nk = __builtin_amdgcn_rsqf(wave_sum(k0 * k0 + k1 * k1) + EPS);
    q0 *= nq; q1 *= nq; k0 *= nk; k1 *= nk;
}
__device__ __forceinline__ void dn_gates(bf16_t rb, bf16_t ra, int lane, float Aexp, float dtb, float& beta, float& G) {
    beta = sigmoidf_(bf1(rb));
    float g = -Aexp * softplusf_(bf1(ra) + dtb);
#pragma unroll
    for (int o = 1; o < 64; o <<= 1) { const float u = __shfl_up(g, o); if (lane >= o) g += u; }
    G = g;
}

__device__ __forceinline__ void prep_gdn_item(LAS unsigned char* lds, const MixArgs& A, int b, int h, int n, bf16_t* Tout, bf16_t* SCout) {
    constexpr int QS = 136, MS = 68;
    int tid = threadIdx.x; asm volatile("" : "+v"(tid));
    const int lane = tid & 63, w = __builtin_amdgcn_readfirstlane(tid >> 6), r = lane & 15, quad = lane >> 4;
    LAS bf16_t* QH = (LAS bf16_t*)lds; LAS bf16_t* KH = QH + 64 * QS; LAS float* MM = (LAS float*)(KH + 64 * QS); LAS bf16_t* TB16 = (LAS bf16_t*)(MM + 64 * MS);
    const bf16_t* seqrow = A.proj + (size_t)b * SEQ * PLD;
    const bf16_t* crow = seqrow + (size_t)n * 64 * PLD;
    float beta, G;
    const bf16_t* hrow = n > 0 ? A.halo + (size_t)(b * NCHUNK + n - 1) * 3 * HALO_LD : nullptr;
    {   DnRaw R; dn_load_rows(R, seqrow, hrow, n * 64, n * 64 + 8 * w, h, lane);
        const bf16_t rb = crow[(size_t)lane * PLD + C_DNB + h], ra = crow[(size_t)lane * PLD + C_DNA + h];
        const int vcol = tid & 127, vtg = tid >> 7;
        unsigned short rvv[19];
#pragma unroll
        for (int i = 0; i < 19; ++i) { const int tt = vtg * 16 - 3 + i;
            rvv[i] = (tt >= 0) ? crow[(size_t)tt * PLD + C_DNV + h * 128 + vcol] : (hrow ? hrow[(size_t)(tt + 3) * HALO_LD + (C_DNV - HALO_C0) + h * 128 + vcol] : (unsigned short)0); }
        float wv4[4];
#pragma unroll
        for (int j = 0; j < 4; ++j) wv4[j] = A.convw[j * 1536 + 1024 + h * 128 + vcol];
        DnConv c; dn_load_conv(c, A.convw, h, lane);
        dn_gates(rb, ra, lane, __expf(A.Alog[h]), A.dtb[h], beta, G);
#define PREP_TOK(I) { const int t = 8 * w + I; float q0, q1, k0, k1; dn_qk_token<I>(c, R, q0, q1, k0, k1); \
            *(LAS unsigned*)(QH + t * QS + 2 * lane) = pk2(q0, q1); *(LAS unsigned*)(KH + t * QS + 2 * lane) = pk2(k0, k1); }
        PREP_TOK(0) PREP_TOK(1) PREP_TOK(2) PREP_TOK(3) PREP_TOK(4) PREP_TOK(5) PREP_TOK(6) PREP_TOK(7)
#undef PREP_TOK
        bf16_t* od = A.odn + ((size_t)b * SEQ + (size_t)n * 64 + vtg * 16) * 512 + h * 128 + vcol;
#pragma unroll
        for (int i = 0; i < 16; ++i) { const float x = wv4[0] * bf1(rvv[i]) + wv4[1] * bf1(rvv[i + 1]) + wv4[2] * bf1(rvv[i + 2]) + wv4[3] * bf1(rvv[i + 3]);
            od[(size_t)i * 512] = (bf16_t)f2bf(siluf_(x) * __shfl(beta, vtg * 16 + i)); }
        { const float g63 = __shfl(G, 63); if (tid == 0) A.dec[DEC_GDN_OFF / 4 + (size_t)(b * 4 + h) * NCHUNK + n] = __expf(g63); }
    }
    LDS_BARRIER();
    {
        bf16_t* grow = A.proj + ((size_t)b * SEQ + (size_t)n * 64) * PLD;
        {   const int t = tid >> 3, sg = tid & 7; const float Gt = __shfl(G, t), eg = __expf(Gt), bg = __shfl(beta, t) * eg;
            bf16_t* drow = grow + (size_t)t * PLD + h * 128 + sg * 16;
#pragma unroll
            for (int hh = 0; hh < 2; ++hh) {
                const bf16x8 q8 = ldsfrag(QH + t * QS + sg * 16 + hh * 8), k8 = ldsfrag(KH + t * QS + sg * 16 + hh * 8);
                u32x4 oq, ok;
                oq.x = pk2(bf1((bf16_t)q8[0]) * eg, bf1((bf16_t)q8[1]) * eg); oq.y = pk2(bf1((bf16_t)q8[2]) * eg, bf1((bf16_t)q8[3]) * eg); oq.z = pk2(bf1((bf16_t)q8[4]) * eg, bf1((bf16_t)q8[5]) * eg); oq.w = pk2(bf1((bf16_t)q8[6]) * eg, bf1((bf16_t)q8[7]) * eg);
                ok.x = pk2(bf1((bf16_t)k8[0]) * bg, bf1((bf16_t)k8[1]) * bg); ok.y = pk2(bf1((bf16_t)k8[2]) * bg, bf1((bf16_t)k8[3]) * bg); ok.z = pk2(bf1((bf16_t)k8[4]) * bg, bf1((bf16_t)k8[5]) * bg); ok.w = pk2(bf1((bf16_t)k8[6]) * bg, bf1((bf16_t)k8[7]) * bg);
                *(u32x4*)(drow + C_DNQ + hh * 8) = oq; *(u32x4*)(drow + C_DNK + hh * 8) = ok; }
        }
        {   const int dd = tid & 127, sq = w >> 1; const float G63 = __shfl(G, 63);
            float kd[16];
#pragma unroll
            for (int i = 0; i < 16; ++i) { const int ss = sq * 16 + i; kd[i] = bf1(KH[ss * QS + dd]) * __expf(G63 - __shfl(G, ss)); }
            bf16_t* kdst = grow + (size_t)(dd >> 1) * PLD + C_DNV + h * 128 + (dd & 1) * 64 + sq * 16;
            u32x4 o0, o1;
            o0.x = pk2(kd[0], kd[1]); o0.y = pk2(kd[2], kd[3]); o0.z = pk2(kd[4], kd[5]); o0.w = pk2(kd[6], kd[7]);
            o1.x = pk2(kd[8], kd[9]); o1.y = pk2(kd[10], kd[11]); o1.z = pk2(kd[12], kd[13]); o1.w = pk2(kd[14], kd[15]);
            *(u32x4*)kdst = o0; *(u32x4*)(kdst + 8) = o1;
        }
    }
#pragma unroll
    for (int q = 0; q < 4; ++q) {
        const int tile = 4 * w + q, isq = tile >> 4, tm = (tile >> 2) & 3, tn = tile & 3;
        const LAS bf16_t* X = isq ? QH : KH;
        f32x4 acc = {0.f, 0.f, 0.f, 0.f};
#pragma unroll
        for (int kk = 0; kk < 4; ++kk) acc = MFMA16(ldsfrag(KH + (16 * tm + r) * QS + 32 * kk + quad * 8), ldsfrag(X + (16 * tn + r) * QS + 32 * kk + quad * 8), acc);
        const int t = 16 * tn + r, s0 = 16 * tm + quad * 4;
        const float Gt = __shfl(G, t), bt = __shfl(beta, t);
        float v[4];
#pragma unroll
        for (int j = 0; j < 4; ++j) { const int s = s0 + j; const float Gs = __shfl(G, s); const float L = __expf(fminf(Gt - Gs, 0.f));
            v[j] = isq ? ((s <= t) ? acc[j] * L : 0.f) : ((s < t) ? acc[j] * L * bt : 0.f); }
        if (isq) { u32x2 o; o.x = pk2(v[0], v[1]); o.y = pk2(v[2], v[3]); *(u32x2*)(SCout + t * 64 + s0) = o; }
        else *(LAS f32x4*)(MM + t * MS + s0) = (f32x4){v[0], v[1], v[2], v[3]};
    }
    LDS_BARRIER();
    {
        const int col = tid >> 3, ds = tid & 7;
        float xs[8];
#pragma unroll
        for (int i = 0; i < 8; ++i) xs[i] = 0.f;
#pragma unroll
        for (int rb = 0; rb < 8; ++rb) {
            float mm[8][8];
#pragma unroll
            for (int j = 0; j < 8; ++j)
#pragma unroll
                for (int i = 0; i <= rb; ++i) mm[j][i] = MM[(8 * rb + j) * MS + 8 * i + ds];
#pragma unroll
            for (int j = 0; j < 8; ++j) {
                const int t = 8 * rb + j;
                float part = 0.f;
#pragma unroll
                for (int i = 0; i <= rb; ++i) part += mm[j][i] * xs[i];
                const float xt = ((t == col) ? 1.f : 0.f) - reduce8(part);
                if (ds == j) xs[rb] = xt;
            }
        }
#pragma unroll
        for (int i = 0; i < 8; ++i) TB16[(8 * i + ds) * 64 + col] = (bf16_t)f2bf(xs[i]);
    }
    LDS_BARRIER();
    *(u32x4*)(Tout + tid * 8) = *(const LAS u32x4*)(TB16 + tid * 8);
    LDS_BARRIER();
}

template <int MIX, int DRYRUN = 0>
__device__ __forceinline__ void chain_gla(LAS unsigned char* lds, const MixArgs& A, int b, int h, int half, const bf16_t* Aaux) {
    constexpr int DK = (MIX == 1) ? 64 : 128, QS = DK + 8, TS = 72, NST = DK / 32, NP = DK / 64;
    int tid = threadIdx.x; asm volatile("" : "+v"(tid));
    const int lane = tid & 63, w = __builtin_amdgcn_readfirstlane(tid >> 6), r = lane & 15, quad = lane >> 4;
    LAS bf16_t* QD = (LAS bf16_t*)lds; LAS bf16_t* KDT = QD + 64 * QS; LAS bf16_t* VT = KDT + DK * TS; LAS bf16_t* ST = VT + 64 * TS;
    LAS float* DEC = (LAS float*)(ST + 64 * QS); LAS bf16_t* AL = (LAS bf16_t*)(DEC + DK); LAS bf16_t* OST = AL + 64 * TS + w * 512;
    const int vc = tid & 63, vg = tid >> 6;
    bf16_t* pbase = A.proj + (size_t)b * SEQ * PLD;
    const int cq0 = (MIX == 0 ? C_HGQ + h * 128 : C_GLQ + h * 64), ck0 = (MIX == 0 ? C_HGF + h * 128 : C_GLK + h * 64), cv = (MIX == 0 ? C_HGI : C_GLV) + h * 128 + half * 64;
    const float* decg = A.dec + (MIX == 0 ? (size_t)0 : DEC_GLA_OFF / 4) + (size_t)(b * 4 + h) * NCHUNK * DK;
    const int tr = w >> 1, tc0 = 2 * (w & 1);
    int sdt[NST], sct[NST];
#pragma unroll
    for (int q = 0; q < NST; ++q) { if (DK == 128) { sdt[q] = w; sct[q] = q; } else { sdt[q] = w >> 1; sct[q] = 2 * (w & 1) + q; } }
    f32x4 Sacc[NST];
#pragma unroll
    for (int q = 0; q < NST; ++q) Sacc[q] = (f32x4){0.f, 0.f, 0.f, 0.f};
    for (int i = tid; i < 64 * QS / 2; i += 512) ((LAS unsigned*)ST)[i] = 0u;
    struct Pre { u32x4 qd[NP], kd[NP], am; unsigned short v[8]; float dec; };
    Pre P0, P1; P0.dec = 0.f; P1.dec = 0.f;
#define GLA_LOAD(P, n_) do { const bf16_t* cr = pbase + (size_t)(n_) * 64 * PLD; \
        _Pragma("unroll") for (int k = 0; k < NP; ++k) { const int p = tid + 512 * k; \
            P.qd[k] = *(const u32x4*)(cr + (size_t)(p / (DK / 8)) * PLD + cq0 + (p % (DK / 8)) * 8); \
            P.kd[k] = *(const u32x4*)(cr + (size_t)(p / (DK / 8)) * PLD + ck0 + (p % (DK / 8)) * 8); } \
        _Pragma("unroll") for (int i = 0; i < 8; ++i) P.v[i] = cr[(size_t)(vg * 8 + i) * PLD + cv + vc]; \
        if (tid < DK) P.dec = decg[(size_t)(n_) * DK + tid]; \
        P.am = *(const u32x4*)(Aaux + (size_t)(n_) * 4096 + tid * 8); } while (0)
    GLA_LOAD(P0, 0); GLA_LOAD(P1, 1);
#define GLA_CHUNK(P, n) do { \
        *(LAS u32x4*)(AL + (tid >> 3) * TS + (tid & 7) * 8) = P.am; \
        _Pragma("unroll") for (int k = 0; k < NP; ++k) { const int p = tid + 512 * k, row = p / (DK / 8), seg = p % (DK / 8); \
            *(LAS u32x4*)(QD + row * QS + seg * 8) = P.qd[k]; \
            const int dd = (DK == 128) ? 2 * row + (seg >> 3) : row, ss = (seg & 7) * 8; \
            *(LAS u32x4*)(KDT + dd * TS + ss) = P.kd[k]; } \
        if (tid < DK) DEC[tid] = P.dec; \
        { u32x4 o; o.x = (unsigned)P.v[0] | ((unsigned)P.v[1] << 16); o.y = (unsigned)P.v[2] | ((unsigned)P.v[3] << 16); o.z = (unsigned)P.v[4] | ((unsigned)P.v[5] << 16); o.w = (unsigned)P.v[6] | ((unsigned)P.v[7] << 16); \
          *(LAS u32x4*)(VT + vc * TS + vg * 8) = o; } \
        { const int nn = ((n) + 2 < NCHUNK) ? (n) + 2 : NCHUNK - 1; GLA_LOAD(P, nn); } \
        gla_body((n)); } while (0)
    auto gla_body = [&](int n) __attribute__((always_inline)) {
        LDS_BARRIER();
        bf16x8 fa[DK / 32], fs[2][DK / 32], fv[2][2], fk[NST][2], fw[NST][2];
#pragma unroll
        for (int kk = 0; kk < DK / 32; ++kk) { fa[kk] = ldsfrag(QD + (16 * tr + r) * QS + 32 * kk + quad * 8);
            fs[0][kk] = ldsfrag(ST + (16 * tc0 + r) * QS + 32 * kk + quad * 8); fs[1][kk] = ldsfrag(ST + (16 * (tc0 + 1) + r) * QS + 32 * kk + quad * 8); }
#pragma unroll
        for (int q = 0; q < 2; ++q) { fv[q][0] = ldsfrag(VT + (16 * (tc0 + q) + r) * TS + quad * 8); fv[q][1] = ldsfrag(VT + (16 * (tc0 + q) + r) * TS + 32 + quad * 8); }
#pragma unroll
        for (int q = 0; q < NST; ++q) { fk[q][0] = ldsfrag(KDT + (16 * sdt[q] + r) * TS + quad * 8); fk[q][1] = ldsfrag(KDT + (16 * sdt[q] + r) * TS + 32 + quad * 8);
            fw[q][0] = ldsfrag(VT + (16 * sct[q] + r) * TS + quad * 8); fw[q][1] = ldsfrag(VT + (16 * sct[q] + r) * TS + 32 + quad * 8); }
        const bf16x8 af0 = ldsfrag(AL + (16 * tr + r) * TS + quad * 8), af1 = ldsfrag(AL + (16 * tr + r) * TS + 32 + quad * 8);
        f32x4 dcv[NST];
#pragma unroll
        for (int q = 0; q < NST; ++q) dcv[q] = *(const LAS f32x4*)(DEC + 16 * sdt[q] + quad * 4);
        f32x4 oa0 = {0.f, 0.f, 0.f, 0.f}, oa1 = {0.f, 0.f, 0.f, 0.f};
#pragma unroll
        for (int kk = 0; kk < DK / 32; ++kk) { oa0 = MFMA16(fa[kk], fs[0][kk], oa0); oa1 = MFMA16(fa[kk], fs[1][kk], oa1); }
        oa0 = MFMA16(af0, fv[0][0], oa0); oa1 = MFMA16(af0, fv[1][0], oa1);
        oa0 = MFMA16(af1, fv[0][1], oa0); oa1 = MFMA16(af1, fv[1][1], oa1);
#pragma unroll
        for (int q = 0; q < NST; ++q) Sacc[q] = Sacc[q] * dcv[q];
#pragma unroll
        for (int q = 0; q < NST; ++q) Sacc[q] = MFMA16(fk[q][0], fw[q][0], Sacc[q]);
#pragma unroll
        for (int q = 0; q < NST; ++q) Sacc[q] = MFMA16(fk[q][1], fw[q][1], Sacc[q]);
#pragma unroll
        for (int j = 0; j < 4; ++j) { OST[(quad * 4 + j) * 32 + r] = (bf16_t)f2bf(oa0[j]); OST[(quad * 4 + j) * 32 + 16 + r] = (bf16_t)f2bf(oa1[j]); }
        LDS_WAIT();
        if (DRYRUN == 0) *(u32x4*)(pbase + (size_t)(n * 64 + 16 * tr + (lane >> 2)) * PLD + cv + 16 * tc0 + (lane & 3) * 8) = *(const LAS u32x4*)(OST + (lane >> 2) * 32 + (lane & 3) * 8);
        LDS_BARRIER();
#pragma unroll
        for (int q = 0; q < NST; ++q) { u32x2 o; o.x = pk2(Sacc[q][0], Sacc[q][1]); o.y = pk2(Sacc[q][2], Sacc[q][3]);
            *(LAS u32x2*)(ST + (16 * sct[q] + r) * QS + 16 * sdt[q] + quad * 4) = o; }
    };
    for (int n = 0; n < NCHUNK; n += 2) { GLA_CHUNK(P0, n); GLA_CHUNK(P1, n + 1); }
#undef GLA_LOAD
#undef GLA_CHUNK
    LDS_BARRIER();
}

template <int DRYRUN = 0>
__device__ __forceinline__ void chain_gdn(LAS unsigned char* lds, const MixArgs& A, int b, int h, int half, const bf16_t* Taux, const bf16_t* SCaux) {
    constexpr int QS = 136, TS = 72, VS = 68;
    int tid = threadIdx.x; asm volatile("" : "+v"(tid));
    const int lane = tid & 63, w = __builtin_amdgcn_readfirstlane(tid >> 6), r = lane & 15, quad = lane >> 4;
    LAS bf16_t* QD = (LAS bf16_t*)lds; LAS bf16_t* KBG = QD + 64 * QS; LAS bf16_t* ST = KBG + 64 * QS; LAS bf16_t* KDT = ST + 64 * QS; LAS bf16_t* XT = KDT + 128 * TS; LAS bf16_t* VNT = XT + 64 * TS;
    LAS bf16_t* VC = VNT + 64 * TS; LAS bf16_t* TL = VC + 64 * TS; LAS bf16_t* SCL = TL + 64 * TS; LAS float* CDL = (LAS float*)(SCL + 64 * TS); LAS bf16_t* OST = (LAS bf16_t*)(CDL + 4) + w * 512;
    const bf16_t* seqrow = A.proj + (size_t)b * SEQ * PLD;
    const float* decg = A.dec + DEC_GDN_OFF / 4 + (size_t)(b * 4 + h) * NCHUNK;
    const int tr = w >> 1, tc0 = 2 * (w & 1);
    f32x4 Sacc[4];
#pragma unroll
    for (int q = 0; q < 4; ++q) Sacc[q] = (f32x4){0.f, 0.f, 0.f, 0.f};
    for (int i = tid; i < 64 * QS / 2; i += 512) ((LAS unsigned*)ST)[i] = 0u;
    bf16_t* obase = A.odn + (size_t)b * SEQ * 512 + h * 128 + half * 64;
    struct Pre { u32x4 qd[2], kb[2], kd[2], vc, tm, sm; float cd; };
    Pre P0, P1;
#define GDN_LOAD(P, n_) do { const bf16_t* cr = seqrow + (size_t)(n_) * 64 * PLD + h * 128; \
        _Pragma("unroll") for (int k = 0; k < 2; ++k) { const int p = tid + 512 * k; const bf16_t* rp = cr + (size_t)(p >> 4) * PLD + (p & 15) * 8; \
            P.qd[k] = *(const u32x4*)(rp + C_DNQ); P.kb[k] = *(const u32x4*)(rp + C_DNK); P.kd[k] = *(const u32x4*)(rp + C_DNV); } \
        P.vc = *(const u32x4*)(obase + (size_t)((n_) * 64 + (tid >> 3)) * 512 + (tid & 7) * 8); \
        P.cd = decg[(n_)]; \
        P.tm = *(const u32x4*)(Taux + (size_t)(n_) * 4096 + tid * 8); P.sm = *(const u32x4*)(SCaux + (size_t)(n_) * 4096 + tid * 8); } while (0)
    GDN_LOAD(P0, 0); GDN_LOAD(P1, 1);
#define GDN_CHUNK(P, n) do { \
        *(LAS u32x4*)(TL + (tid >> 3) * TS + (tid & 7) * 8) = P.tm; *(LAS u32x4*)(SCL + (tid >> 3) * TS + (tid & 7) * 8) = P.sm; if (tid == 0) CDL[0] = P.cd; \
        _Pragma("unroll") for (int k = 0; k < 2; ++k) { const int p = tid + 512 * k, row = p >> 4, seg = p & 15; \
            *(LAS u32x4*)(QD + row * QS + seg * 8) = P.qd[k]; *(LAS u32x4*)(KBG + row * QS + seg * 8) = P.kb[k]; \
            *(LAS u32x4*)(KDT + (2 * row + (seg >> 3)) * TS + (seg & 7) * 8) = P.kd[k]; } \
        *(LAS u32x4*)(VC + (tid >> 3) * TS + (tid & 7) * 8) = P.vc; \
        { const int nn = ((n) + 2 < NCHUNK) ? (n) + 2 : NCHUNK - 1; GDN_LOAD(P, nn); } \
        gdn_body((n)); } while (0)
    auto gdn_body = [&](int n) __attribute__((always_inline)) {
        LDS_BARRIER();
        bf16x8 fs[2][4], fq[4];
        {   bf16x8 fkb[4];
#pragma unroll
            for (int kk = 0; kk < 4; ++kk) { fkb[kk] = ldsfrag(KBG + (16 * tr + r) * QS + 32 * kk + quad * 8); fq[kk] = ldsfrag(QD + (16 * tr + r) * QS + 32 * kk + quad * 8);
                fs[0][kk] = ldsfrag(ST + (16 * tc0 + r) * QS + 32 * kk + quad * 8); fs[1][kk] = ldsfrag(ST + (16 * (tc0 + 1) + r) * QS + 32 * kk + quad * 8); }
            float vc0[4], vc1[4];
#pragma unroll
            for (int j = 0; j < 4; ++j) { vc0[j] = bf1(VC[(16 * tr + quad * 4 + j) * TS + 16 * tc0 + r]); vc1[j] = bf1(VC[(16 * tr + quad * 4 + j) * TS + 16 * (tc0 + 1) + r]); }
            f32x4 x0 = {0.f, 0.f, 0.f, 0.f}, x1 = {0.f, 0.f, 0.f, 0.f};
#pragma unroll
            for (int kk = 0; kk < 4; ++kk) { x0 = MFMA16(fkb[kk], fs[0][kk], x0); x1 = MFMA16(fkb[kk], fs[1][kk], x1); }
            u32x2 o; o.x = pk2(vc0[0] - x0[0], vc0[1] - x0[1]); o.y = pk2(vc0[2] - x0[2], vc0[3] - x0[3]);
            *(LAS u32x2*)(XT + (16 * tc0 + r) * TS + 16 * tr + quad * 4) = o;
            o.x = pk2(vc1[0] - x1[0], vc1[1] - x1[1]); o.y = pk2(vc1[2] - x1[2], vc1[3] - x1[3]);
            *(LAS u32x2*)(XT + (16 * (tc0 + 1) + r) * TS + 16 * tr + quad * 4) = o;
        }
        LDS_BARRIER();
        {   const bf16x8 tf0 = ldsfrag(TL + (16 * tr + r) * TS + quad * 8), tf1 = ldsfrag(TL + (16 * tr + r) * TS + 32 + quad * 8);
            const bf16x8 b00 = ldsfrag(XT + (16 * tc0 + r) * TS + quad * 8), b01 = ldsfrag(XT + (16 * tc0 + r) * TS + 32 + quad * 8);
            const bf16x8 b10 = ldsfrag(XT + (16 * (tc0 + 1) + r) * TS + quad * 8), b11 = ldsfrag(XT + (16 * (tc0 + 1) + r) * TS + 32 + quad * 8);
            f32x4 v0 = {0.f, 0.f, 0.f, 0.f}, v1 = {0.f, 0.f, 0.f, 0.f};
            v0 = MFMA16(tf0, b00, v0); v1 = MFMA16(tf0, b10, v1); v0 = MFMA16(tf1, b01, v0); v1 = MFMA16(tf1, b11, v1);
            u32x2 o; o.x = pk2(v0[0], v0[1]); o.y = pk2(v0[2], v0[3]);
            *(LAS u32x2*)(VNT + (16 * tc0 + r) * TS + 16 * tr + quad * 4) = o;
            o.x = pk2(v1[0], v1[1]); o.y = pk2(v1[2], v1[3]);
            *(LAS u32x2*)(VNT + (16 * (tc0 + 1) + r) * TS + 16 * tr + quad * 4) = o;
        }
        LDS_BARRIER();
        {   bf16x8 fw[4][2], fk[2];
#pragma unroll
            for (int q = 0; q < 4; ++q) { fw[q][0] = ldsfrag(VNT + (16 * q + r) * TS + quad * 8); fw[q][1] = ldsfrag(VNT + (16 * q + r) * TS + 32 + quad * 8); }
            fk[0] = ldsfrag(KDT + (16 * w + r) * TS + quad * 8); fk[1] = ldsfrag(KDT + (16 * w + r) * TS + 32 + quad * 8);
            const bf16x8 sf0 = ldsfrag(SCL + (16 * tr + r) * TS + quad * 8), sf1 = ldsfrag(SCL + (16 * tr + r) * TS + 32 + quad * 8); const float cd = CDL[0];
            f32x4 oa0 = {0.f, 0.f, 0.f, 0.f}, oa1 = {0.f, 0.f, 0.f, 0.f};
#pragma unroll
            for (int kk = 0; kk < 4; ++kk) { oa0 = MFMA16(fq[kk], fs[0][kk], oa0); oa1 = MFMA16(fq[kk], fs[1][kk], oa1); }
#pragma unroll
            for (int q = 0; q < 4; ++q) Sacc[q] = Sacc[q] * cd;
#pragma unroll
            for (int q = 0; q < 4; ++q) Sacc[q] = MFMA16(fk[0], fw[q][0], Sacc[q]);
            const bf16x8 g00 = (tc0 == 0) ? fw[0][0] : fw[2][0], g01 = (tc0 == 0) ? fw[0][1] : fw[2][1], g10 = (tc0 == 0) ? fw[1][0] : fw[3][0], g11 = (tc0 == 0) ? fw[1][1] : fw[3][1];
            oa0 = MFMA16(sf0, g00, oa0); oa1 = MFMA16(sf0, g10, oa1);
#pragma unroll
            for (int q = 0; q < 4; ++q) Sacc[q] = MFMA16(fk[1], fw[q][1], Sacc[q]);
            oa0 = MFMA16(sf1, g01, oa0); oa1 = MFMA16(sf1, g11, oa1);
#pragma unroll
            for (int j = 0; j < 4; ++j) { OST[(quad * 4 + j) * 32 + r] = (bf16_t)f2bf(oa0[j]); OST[(quad * 4 + j) * 32 + 16 + r] = (bf16_t)f2bf(oa1[j]); }
            LDS_WAIT();
            if (DRYRUN == 0) *(u32x4*)(obase + (size_t)(n * 64 + 16 * tr + (lane >> 2)) * 512 + 16 * tc0 + (lane & 3) * 8) = *(const LAS u32x4*)(OST + (lane >> 2) * 32 + (lane & 3) * 8);
        }
        LDS_BARRIER();
#pragma unroll
        for (int q = 0; q < 4; ++q) { u32x2 o; o.x = pk2(Sacc[q][0], Sacc[q][1]); o.y = pk2(Sacc[q][2], Sacc[q][3]);
            *(LAS u32x2*)(ST + (16 * q + r) * QS + 16 * w + quad * 4) = o; }
    };
    for (int n = 0; n < NCHUNK; n += 2) { GDN_CHUNK(P0, n); GDN_CHUNK(P1, n + 1); }
#undef GDN_LOAD
#undef GDN_CHUNK
    LDS_BARRIER();
}

#define XB_TMO      128
#define XB_XCNT(j)  (256  + 64 * (j))
#define XB_XSUB(j)  (1280 + 64 * (j))
#define XB_XGEN(j)  (2304 + 64 * (j))
#define XB_TOP      3328
#define XB_TOPGEN   3392
#define XCD_BAR_WORDS 3456
#define XB_SPIN_CAP (1u << 18)

__device__ __forceinline__ unsigned xb_ld(unsigned* p)              { return __hip_atomic_load(p, __ATOMIC_RELAXED, __HIP_MEMORY_SCOPE_AGENT); }
__device__ __forceinline__ unsigned xb_add(unsigned* p, unsigned v) { return __hip_atomic_fetch_add(p, v, __ATOMIC_RELAXED, __HIP_MEMORY_SCOPE_AGENT); }
__device__ __forceinline__ unsigned xb_xcc_id() { return (unsigned)__builtin_amdgcn_s_getreg((3 << 11) | 20) & 0xFu; }
#define XB_SPIN(cond, bar) do { unsigned _sp = 0; while (cond) { __builtin_amdgcn_s_sleep(1); \
    if ((++_sp & 255u) == 0u) { if (xb_ld(&(bar)[XB_TMO])) break; if (_sp > XB_SPIN_CAP) { atomicAdd(&(bar)[XB_TMO], 1u); break; } } } } while (0)

struct XcdBarrier {
    unsigned* bar; unsigned x;
    volatile LAS unsigned* st;
};

__device__ __forceinline__ XcdBarrier xcd_barrier_post(unsigned* bar, volatile LAS unsigned* st) {
    XcdBarrier b; b.bar = bar; b.x = xb_xcc_id(); b.st = st;
    if (threadIdx.x == 0) (void)xb_add(&bar[XB_XCNT(b.x)], 1u);
    return b;
}
__device__ __forceinline__ void xcd_barrier_complete(unsigned* bar, unsigned x, unsigned& nloc, unsigned& nx) {
    const unsigned G = gridDim.x * gridDim.y * gridDim.z;
    unsigned sum, cnt, mine, sp = 0u;
    for (;;) {
        sum = 0u; cnt = 0u; mine = 0u;
#pragma unroll
        for (unsigned j = 0; j < 16; ++j) { const unsigned c = xb_ld(&bar[XB_XCNT(j)]); sum += c; cnt += (c > 0u) ? 1u : 0u; mine = (j == x) ? c : mine; }
        if (sum == G) break;
        __builtin_amdgcn_s_sleep(1);
        if ((++sp & 255u) == 0u) { if (xb_ld(&bar[XB_TMO])) break; if (sp > XB_SPIN_CAP) { atomicAdd(&bar[XB_TMO], 1u); break; } }
    }
    nloc = mine > 0u ? mine : 1u; nx = cnt > 0u ? cnt : 1u;
}

__device__ __forceinline__ void xcd_barrier(const XcdBarrier& b) {
    asm volatile("s_waitcnt vmcnt(0)" ::: "memory");
    __syncthreads();
    if (threadIdx.x == 0) {
        unsigned* bar = b.bar;
        __builtin_amdgcn_s_waitcnt(0);
        unsigned nloc = b.st[0], nx = b.st[1];
        if (nloc == 0u) { xcd_barrier_complete(bar, b.x, nloc, nx); b.st[0] = nloc; b.st[1] = nx; }
        const unsigned old = xb_add(&bar[XB_XSUB(b.x)], 1u);
        const unsigned gen = old / nloc;
        if (old + 1u == (gen + 1u) * nloc) {
            __builtin_amdgcn_fence(__ATOMIC_RELEASE, "agent");
            asm volatile("s_waitcnt vmcnt(0)" ::: "memory");
            const unsigned og = xb_add(&bar[XB_TOP], 1u);
            const unsigned tg = og / nx;
            if (og + 1u == (tg + 1u) * nx) xb_add(&bar[XB_TOPGEN], 1u);
            else XB_SPIN(xb_ld(&bar[XB_TOPGEN]) == tg, bar);
            __builtin_amdgcn_fence(__ATOMIC_ACQUIRE, "agent");
            xb_add(&bar[XB_XGEN(b.x)], 1u);
            asm volatile("s_waitcnt vmcnt(0)" ::: "memory");
        } else {
            XB_SPIN(xb_ld(&bar[XB_XGEN(b.x)]) == gen, bar);
            __builtin_amdgcn_fence(__ATOMIC_ACQUIRE, "agent");
            asm volatile("s_waitcnt vmcnt(0)" ::: "memory");
        }
    }
    __syncthreads();
}

__global__ void __launch_bounds__(512, 2) fwd_megakernel(Args args) {
    extern __shared__ __attribute__((aligned(16))) unsigned char lds_raw[];
    LAS unsigned char* lds = (LAS unsigned char*)lds_raw;
    cg::grid_group grid = cg::this_grid();
    const int G = gridDim.x, bx = blockIdx.x, NGW = G * 8;
    volatile LAS unsigned* bst = (volatile LAS unsigned*)(lds + 131072 + 64);
    if (threadIdx.x < 4) bst[threadIdx.x] = 0u;
    __syncthreads();
    const XcdBarrier xbar = xcd_barrier_post((unsigned*)(args.ws + WS_CTL), bst);
#define OPAQUE_TID() int tid = threadIdx.x; asm volatile("" : "+v"(tid)); const int lane = tid & 63, wave = __builtin_amdgcn_readfirstlane(tid >> 6), gw = bx * 8 + wave; (void)lane; (void)gw
    unsigned char* ws = args.ws;
    const float* x_in = args.in[0];
    float* xres = args.out;
    bf16_t* HB = (bf16_t*)(ws + WS_HB);
    bf16_t* PROJ = (bf16_t*)(ws + WS_PROJ);
    bf16_t* ODN = (bf16_t*)(ws + WS_ODN);
    bf16_t* UH = (bf16_t*)(ws + WS_U);
    bf16_t* GACT = (bf16_t*)(ws + WS_GACT);
    bf16_t* XB2 = (bf16_t*)(ws + WS_XB2);
    float* SSQ1 = (float*)(ws + WS_SSQ1); float* SSQ2 = (float*)(ws + WS_SSQ2);

    {
        OPAQUE_TID();
        LAS float* scr = (LAS float*)(lds + wave * 16384);
#define CONVERT_WIN(l_, gw_, ngw_) do { unsigned char* lw_ = ws + WS_W + (size_t)(l_) * LW_BYTES; \
            transpose_weight(args.in[2] + (size_t)(l_) * DM * INW, DM, INW, RmWin{(bf16_t*)(lw_ + LW_WIN), (bf16_t*)(lw_ + LW_WG)}, scr, gw_, ngw_, lane, args.in[1] + (size_t)(l_) * DM); } while (0)
#define CONVERT_REST(l_, gw_, ngw_) do { unsigned char* lw_ = ws + WS_W + (size_t)(l_) * LW_BYTES; \
            for (int n_ = 0; n_ < 3; ++n_) \
                transpose_weight(args.in[12] + ((size_t)(l_) * 3 + n_) * 512 * DM, 512, DM, RmPlain{(bf16_t*)(lw_ + LW_WBR) + (size_t)n_ * DM * 512, 512}, scr, gw_, ngw_, lane); \
            transpose_weight(args.in[14] + (size_t)(l_) * DM * DM, DM, DM, RmPlain{(bf16_t*)(lw_ + LW_WOUT), DM}, scr, gw_, ngw_, lane); \
            transpose_weight(args.in[16] + (size_t)(l_) * DM * UPN, DM, UPN, RmUp{(bf16_t*)(lw_ + LW_WUP)}, scr, gw_, ngw_, lane, args.in[15] + (size_t)(l_) * DM); \
            transpose_weight(args.in[19] + (size_t)(l_) * FFH * DM, FFH, DM, RmPlain{(bf16_t*)(lw_ + LW_WDN), FFH}, scr, gw_, ngw_, lane); } while (0)
        CONVERT_WIN(0, gw, NGW);
        if (G <= 192) { CONVERT_REST(0, gw, NGW); CONVERT_WIN(1, gw, NGW); CONVERT_REST(1, gw, NGW); }
        conv_rows_bf16(x_in, HB, SSQ1, gw, NGW, lane);
        for (int i = bx * 512 + tid; i < T; i += G * 512) SSQ2[i] = 0.f;
    }
    grid.sync();

    for (int l = 0; l < DEPTH; ++l) {
        unsigned char* lw = ws + WS_W + (size_t)l * LW_BYTES;
        const float* xi = (l == 0) ? x_in : xres;
        { pg8::Gemm g{HB, (const bf16_t*)(lw + LW_WIN), DM, DM, 0, 0, 0}; pg8::StaticOrder S; S.init(T, PLD, G, bx);
          pg8::EpiProj E{PROJ, PLD, (bf16_t*)(ws + WS_HALO), SSQ1}; pg8::gemm_phase(lds, g, S, E); }
        xcd_barrier(xbar);
        {
            MixArgs A{PROJ, ODN, (const bf16_t*)(ws + WS_HALO), (float*)(ws + WS_DEC), args.in[3], l, args.in[5] + (size_t)l * 16 * 256, args.in[6] + (size_t)l * 256, args.in[8] + (size_t)l * 4 * 1536, args.in[9] + (size_t)l * 4, args.in[10] + (size_t)l * 4};
            bf16_t* AUX = (l == 0) ? (bf16_t*)xres : HB;
            constexpr size_t SLOT_E = AUX_SLOT / 2;
#if CH_GLA || CH_GDN
            for (int it = bx; it < 3 * 4096; it += G) {
                const int mix = it % 3, ch = it / 3, n = ch & 127, bh = ch >> 7, b = bh >> 2, h = bh & 3;
                if (mix == 0) { if (CH_GLA) prep_gla_item<0>(lds, A, b, h, n, AUX + 0 * SLOT_E + (size_t)ch * 4096); }
                else if (mix == 1) { if (CH_GLA) prep_gla_item<1>(lds, A, b, h, n, AUX + 1 * SLOT_E + (size_t)ch * 4096); }
                else { if (CH_GDN) prep_gdn_item(lds, A, b, h, n, AUX + 2 * SLOT_E + (size_t)ch * 4096, AUX + 3 * SLOT_E + (size_t)ch * 4096); }
            }
            xcd_barrier(xbar);
#endif
            if (bx < 192) {
                const int xcd = bx & 7, slot = bx >> 3, half = slot & 1, cid = (slot >> 1) * 8 + xcd, mix = cid % 3, bh = cid / 3, b = bh >> 2, h = bh & 3;
                if (mix == 0) { if (CH_GLA) chain_gla<0>(lds, A, b, h, half, AUX + 0 * SLOT_E + (size_t)bh * 128 * 4096); else mixer_chain<0>(lds, A, b, h, half); }
                else if (mix == 1) { if (CH_GLA) chain_gla<1>(lds, A, b, h, half, AUX + 1 * SLOT_E + (size_t)bh * 128 * 4096); else mixer_chain<1>(lds, A, b, h, half); }
                else { if (CH_GDN) chain_gdn(lds, A, b, h, half, AUX + 2 * SLOT_E + (size_t)bh * 128 * 4096, AUX + 3 * SLOT_E + (size_t)bh * 128 * 4096); else mixer_chain<2>(lds, A, b, h, half); }
            } else if (l == 0) {
                OPAQUE_TID(); LAS float* scr = (LAS float*)(lds + wave * 16384);
                CONVERT_REST(0, (bx - 192) * 8 + wave, (G - 192) * 8); CONVERT_WIN(1, (bx - 192) * 8 + wave, (G - 192) * 8); CONVERT_REST(1, (bx - 192) * 8 + wave, (G - 192) * 8);
            }
        }
        xcd_barrier(xbar);
        { OPAQUE_TID(); hnorm_phase(PROJ, ODN, args.in[4] + (size_t)l * 128, args.in[7] + (size_t)l * 128, args.in[11] + (size_t)l * 128, gw, NGW, lane);
          if (l != 0) conv_rows_bf16(xi, HB, nullptr, gw, NGW, lane);
        }
        xcd_barrier(xbar);
        { pg8::Gemm g{HB, (const bf16_t*)(lw + LW_WG), DM, DM, 0, 0, 0}; pg8::StaticOrder S; S.init(T, 3072, G, bx);
          pg8::EpiGate E{PROJ, args.in[13] + (size_t)l * 3072, SSQ1}; pg8::gemm_phase(lds, g, S, E); }
        xcd_barrier(xbar);
        { pg8::Gemm g{PROJ + C_HGI, (const bf16_t*)(lw + LW_WBR), PLD, 512, (size_t)DM * 512 * 2, (size_t)(C_GLV - C_HGI) * 2, (size_t)(C_DNV - C_HGI) * 2};
          pg8::BranchOrder S; S.base.init(T, DM, G, bx);
          pg8::EpiBranch E{PROJ, HB}; pg8::gemm_phase(lds, g, S, E); }
        xcd_barrier(xbar);
        { pg8::Gemm g{HB, (const bf16_t*)(lw + LW_WOUT), DM, DM, 0, 0, 0}; pg8::StaticOrder S; S.init(T, DM, G, bx);
          pg8::EpiResid E{xi, xres, XB2, SSQ2}; pg8::gemm_phase(lds, g, S, E); }
        xcd_barrier(xbar);
        for (int hf = 0; hf < 2; ++hf) {
            { pg8::Gemm g{XB2 + (size_t)hf * TH * DM, (const bf16_t*)(lw + LW_WUP), DM, DM, 0, 0, 0}; pg8::StaticOrder S; S.init(TH, UPN, G, bx);
              pg8::EpiBf16 E{UH, UPN, SSQ2 + (size_t)hf * TH}; pg8::gemm_phase(lds, g, S, E); }
            xcd_barrier(xbar);
            { OPAQUE_TID(); convgate_phase(UH, GACT, args.in[17] + (size_t)l * 3 * UPN, args.in[18] + (size_t)l * UPN, bx * 512 + tid, G * 512);
              if (l + 1 < DEPTH) { float* z = (hf == 0) ? SSQ1 : SSQ2; for (int i = bx * 512 + tid; i < T; i += G * 512) z[i] = 0.f; } }
            xcd_barrier(xbar);
            { pg8::Gemm g{GACT, (const bf16_t*)(lw + LW_WDN), FFH, FFH, 0, 0, 0}; pg8::StaticOrder S; S.init(TH, DM, G, bx);
              pg8::EpiResid E{xres + (size_t)hf * TH * DM, xres + (size_t)hf * TH * DM, (l + 1 < DEPTH) ? HB + (size_t)hf * TH * DM : nullptr, SSQ1 + (size_t)hf * TH}; pg8::gemm_phase(lds, g, S, E); }
            if (hf == 1) xcd_barrier(xbar);
        }
    }
    { OPAQUE_TID(); norm_rows_f32_inplace(xres, args.in[20], gw, NGW, lane); }
}

extern "C" void kernel_launch(void* const* d_in, const int* in_sizes, int n_in, void* d_out, int out_size, void* d_ws, size_t ws_size, hipStream_t stream) {
    static int grid = 0;
    if (grid == 0) {
        if (n_in != 21 || out_size != T * DM || ws_size < 1024 * MiB) { fprintf(stderr, "kernel_launch: unexpected shapes (n_in %d out %d ws %zu)\n", n_in, out_size, ws_size); grid = -1; return; }
        int dev = 0, cus = 0, per_cu = 0;
        hipGetDevice(&dev); hipDeviceGetAttribute(&cus, hipDeviceAttributeMultiprocessorCount, dev);
        if (hipFuncSetAttribute((const void*)fwd_megakernel, hipFuncAttributeMaxDynamicSharedMemorySize, LDS_BYTES) != hipSuccess) { fprintf(stderr, "kernel_launch: hipFuncSetAttribute failed\n"); grid = -1; return; }
        if (hipOccupancyMaxActiveBlocksPerMultiprocessor(&per_cu, (const void*)fwd_megakernel, 512, LDS_BYTES) != hipSuccess || per_cu < 1) { fprintf(stderr, "kernel_launch: occupancy query %d\n", per_cu); per_cu = 1; }
        (void)hipGetLastError();
        grid = cus;
    }
    if (grid < 0) return;
    if (hipMemsetAsync((char*)d_ws + WS_CTL, 0, CTL_BYTES, stream) != hipSuccess) { fprintf(stderr, "kernel_launch: memset failed\n"); return; }
    Args a{};
    for (int i = 0; i < 21; ++i) a.in[i] = (const float*)d_in[i];
    a.out = (float*)d_out; a.ws = (unsigned char*)d_ws;
    void* kargs[] = {&a};
    hipError_t e = hipLaunchCooperativeKernel((const void*)fwd_megakernel, dim3(grid), dim3(512), kargs, LDS_BYTES, stream);
    if (e != hipSuccess) fprintf(stderr, "cooperative launch failed: %s (grid %d)\n", hipGetErrorString(e), grid);
}
```

```cpp
#include <hip/hip_runtime.h>
#include <hip/hip_cooperative_groups.h>
#include <cstdio>
#include <cstdint>
namespace cg = cooperative_groups;
#ifndef CH_GLA
#define CH_GLA 1
#endif
#ifndef CH_GDN
#define CH_GDN 1
#endif

#define LAS __attribute__((address_space(3)))
typedef unsigned short bf16_t;
typedef short bf16x8 __attribute__((ext_vector_type(8)));
typedef float f32x4 __attribute__((ext_vector_type(4)));
typedef unsigned u32x4 __attribute__((ext_vector_type(4)));
typedef unsigned u32x2 __attribute__((ext_vector_type(2)));

constexpr int T = 65536, DM = 1024, SEQ = 8192, NBATCH = 8, DEPTH = 2;
constexpr int PLD = 5888;
constexpr int NMIXCOL = 5656, INW = 8728;
constexpr int FFH = 2816, UPN = 5632;
constexpr int TH = T / 2;
constexpr float EPS = 1e-6f;
constexpr int C_HGQ = 0, C_HGF = 512, C_HGI = 1024, C_HGG = 1536, C_GLQ = 2048, C_GLK = 2304, C_GLV = 2560, C_GLGK = 3072, C_GLG = 3088,
              C_DNQ = 3600, C_DNK = 4112, C_DNV = 4624, C_DNZ = 5136, C_DNB = 5648, C_DNA = 5652;
constexpr int C_GATE0 = 0, C_GATE1 = 1536, C_GATE2 = 3072;

constexpr size_t MiB = 1u << 20;
constexpr size_t LW_WIN = 0, LW_WG = LW_WIN + (size_t)PLD * DM * 2, LW_WBR = LW_WG + (size_t)3072 * DM * 2, LW_WOUT = LW_WBR + (size_t)3 * DM * 512 * 2,
                 LW_WUP = LW_WOUT + (size_t)DM * DM * 2, LW_WDN = LW_WUP + (size_t)UPN * DM * 2, LW_BYTES = LW_WDN + (size_t)DM * FFH * 2;
static_assert(LW_BYTES == 39 * MiB, "layer weight block");
constexpr size_t WS_W = 0, WS_HB = 80 * MiB, WS_PROJ = 208 * MiB, WS_ODN = 944 * MiB, WS_END = 1008 * MiB;
constexpr size_t WS_CTL = 1008 * MiB, CTL_BYTES = 16384;
constexpr size_t WS_HALO = 1009 * MiB;
constexpr int HALO_C0 = 3584, HALO_LD = 1792;
static_assert(WS_HALO + (size_t)(T / 64) * 3 * HALO_LD * 2 <= 1020 * MiB, "halo map");
constexpr size_t WS_DEC = 1020 * MiB;
constexpr size_t DEC_GLA_OFF = 2 * MiB, DEC_GDN_OFF = 3 * MiB;
constexpr size_t WS_SSQ1 = 78 * MiB, WS_SSQ2 = 79 * MiB;
constexpr size_t WS_XB2 = WS_PROJ + 600 * MiB;
constexpr size_t WS_U = WS_PROJ, WS_GACT = WS_PROJ + (size_t)TH * UPN * 2;
static_assert(WS_HB + (size_t)T * DM * 2 <= WS_PROJ && WS_PROJ + (size_t)T * PLD * 2 <= WS_ODN && WS_ODN + (size_t)T * 512 * 2 <= WS_END, "ws map");
static_assert(WS_GACT + (size_t)TH * FFH * 2 <= WS_ODN, "ffn map");

constexpr int LDS_BYTES = 147456;

typedef float f32x2_t __attribute__((ext_vector_type(2)));
typedef __bf16 bf16x2_t __attribute__((ext_vector_type(2)));
__device__ __forceinline__ unsigned pk2(float lo, float hi) { const f32x2_t v = {lo, hi}; const bf16x2_t b = __builtin_convertvector(v, bf16x2_t); return __builtin_bit_cast(unsigned, b); }
__device__ __forceinline__ unsigned f2bf(float f) { return pk2(f, 0.f) & 0xffffu; }
__device__ __forceinline__ float bflo(unsigned u) { return __builtin_bit_cast(float, u << 16); }
__device__ __forceinline__ float bfhi(unsigned u) { return __builtin_bit_cast(float, u & 0xffff0000u); }
__device__ __forceinline__ float bf1(bf16_t h) { return __builtin_bit_cast(float, (unsigned)h << 16); }
__device__ __forceinline__ float sigmoidf_(float x) { return __builtin_amdgcn_rcpf(1.f + __expf(-x)); }
__device__ __forceinline__ float siluf_(float x) { return x * __builtin_amdgcn_rcpf(1.f + __expf(-x)); }
__device__ __forceinline__ float softplusf_(float x) { return fmaxf(x, 0.f) + __logf(1.f + __expf(-fabsf(x))); }
template <int CTRL> __device__ __forceinline__ float dppf(float x) {
    return __builtin_bit_cast(float, __builtin_amdgcn_update_dpp(0, __builtin_bit_cast(int, x), CTRL, 0xF, 0xF, true));
}
__device__ __forceinline__ float reduce8(float x) {
    x += dppf<0xB1>(x); x += dppf<0x4E>(x); x += dppf<0x141>(x); return x;
}
__device__ __forceinline__ float reduce16(float x) {
    x = reduce8(x); x += dppf<0x140>(x); return x;
}
__device__ __forceinline__ float wave_sum(float x) {
    x = reduce16(x);
    const int xi = __builtin_bit_cast(int, x);
    return (__builtin_bit_cast(float, __builtin_amdgcn_readlane(xi, 0)) + __builtin_bit_cast(float, __builtin_amdgcn_readlane(xi, 16)))
         + (__builtin_bit_cast(float, __builtin_amdgcn_readlane(xi, 32)) + __builtin_bit_cast(float, __builtin_amdgcn_readlane(xi, 48)));
}
#define LDS_WAIT() asm volatile("s_waitcnt lgkmcnt(0)" ::: "memory")
#define LDS_BARRIER() asm volatile("s_waitcnt lgkmcnt(0)\n\ts_barrier" ::: "memory")

namespace pg8 {
constexpr int BM = 256, BK = 64, HALF = 128, HTB = HALF * BK * 2, NXCD = 8, WGM = 8;
__host__ __device__ __forceinline__ int lds_byte(int r, int c) { const int st = (r >> 4) * 2 + (c >> 5), rr = r & 15, cc = c & 31, ob = rr * 64 + cc * 2; return st * 1024 + (ob ^ (((ob >> 9) & 1) << 5)); }
__host__ __device__ __forceinline__ void stage_rc(int b, int& R, int& C) { const int st = b / 1024, sb = b % 1024, swz = sb ^ (((sb >> 9) & 1) << 5); R = (st >> 1) * 16 + swz / 64; C = (st & 1) * 32 + (swz % 64) / 2; }
__host__ __device__ __forceinline__ int perm32(int rho) { const int n = rho >> 4, i = rho & 15; return 8 * (i >> 2) + 4 * n + (i & 3); }

struct Unit { int pm, pn, z; };
struct Gemm { const bf16_t* A; const bf16_t* Bt; int lda; int K; size_t zB; size_t zA1, zA2;
    __device__ __forceinline__ size_t zA(int z) const { return z == 0 ? (size_t)0 : (z == 1 ? zA1 : zA2); } };

struct StaticOrder {
    int nM, nN, nwg, G, c;
    __device__ void init(int M, int N, int G_, int c_) { nM = M / BM; nN = N / BM; nwg = nM * nN; G = G_; c = c_; }
    __device__ __forceinline__ bool next(int i, Unit& u) const {
        const long L = (long)i * G + c; if (L >= nwg) return false;
        int wgid = (int)L; { const int q = nwg / NXCD, r = nwg % NXCD, xcd = wgid % NXCD, off = wgid / NXCD; wgid = (xcd < r ? xcd * (q + 1) : r * (q + 1) + (xcd - r) * q) + off; }
        const int nig = WGM * nN, gid = wgid / nig, fm = gid * WGM, gsz = (nM - fm) < WGM ? (nM - fm) : WGM;
        u.pm = fm + ((wgid % nig) % gsz); u.pn = (wgid % nig) / gsz; u.z = 0; return true;
    }
};
struct BranchOrder {
    StaticOrder base;
    __device__ __forceinline__ bool next(int i, Unit& u) const { if (!base.next(i / 3, u)) return false; u.z = i % 3; return true; }
};

typedef f32x4 Acc[2][2][4][2];

struct EpiBf16 {
    bf16_t* O; int ldc; const float* ssq;
    __device__ __forceinline__ bool reset(const Unit&) const { return true; }
    __device__ __forceinline__ void operator()(Acc& acc, const Unit& u, int wr, int wc, int fr, int fq) const {
        const int row0 = u.pm * BM + wr * 64 + fr, col0 = u.pn * BM + wc * 32 + 8 * fq;
        float rsv[2][4];
#pragma unroll
        for (int ai = 0; ai < 2; ++ai)
#pragma unroll
            for (int m = 0; m < 4; ++m) rsv[ai][m] = ssq[row0 + ai * HALF + m * 16];
#pragma unroll
        for (int ai = 0; ai < 2; ++ai)
#pragma unroll
            for (int m = 0; m < 4; ++m) { bf16_t* rowp = O + (size_t)(row0 + ai * HALF + m * 16) * ldc + col0; const float rs = rsqrtf(rsv[ai][m] * (1.f / DM) + EPS);
#pragma unroll
                for (int bj = 0; bj < 2; ++bj) { const f32x4 v0 = acc[ai][bj][m][0] * rs, v1 = acc[ai][bj][m][1] * rs;
                    u32x4 w; w.x = pk2(v0[0], v0[1]); w.y = pk2(v0[2], v0[3]); w.z = pk2(v1[0], v1[1]); w.w = pk2(v1[2], v1[3]);
                    *(u32x4*)(rowp + bj * HALF) = w; } }
    }
};
struct EpiProj {
    bf16_t* O; int ldc; bf16_t* H; const float* ssq;
    __device__ __forceinline__ bool reset(const Unit&) const { return true; }
    __device__ __forceinline__ void operator()(Acc& acc, const Unit& u, int wr, int wc, int fr, int fq) const {
        const int row0 = u.pm * BM + wr * 64 + fr, col0 = u.pn * BM + wc * 32 + 8 * fq;
        const bool halo = (u.pn >= 14) && (u.pn <= 20) && (fr >= 13);
        float rsv[2][4];
#pragma unroll
        for (int ai = 0; ai < 2; ++ai)
#pragma unroll
            for (int m = 0; m < 4; ++m) rsv[ai][m] = ssq[row0 + ai * HALF + m * 16];
#pragma unroll
        for (int ai = 0; ai < 2; ++ai)
#pragma unroll
            for (int m = 0; m < 4; ++m) { const int row = row0 + ai * HALF + m * 16; bf16_t* rowp = O + (size_t)row * ldc + col0; const float rs = rsqrtf(rsv[ai][m] * (1.f / DM) + EPS);
#pragma unroll
                for (int bj = 0; bj < 2; ++bj) { const f32x4 v0 = acc[ai][bj][m][0] * rs, v1 = acc[ai][bj][m][1] * rs;
                    u32x4 w; w.x = pk2(v0[0], v0[1]); w.y = pk2(v0[2], v0[3]); w.z = pk2(v1[0], v1[1]); w.w = pk2(v1[2], v1[3]);
                    *(u32x4*)(rowp + bj * HALF) = w;
                    if (m == 3 && halo) *(u32x4*)(H + ((size_t)(row >> 6) * 3 + (fr - 13)) * HALO_LD + (col0 + bj * HALF - HALO_C0)) = w; } }
    }
};
struct EpiGate {
    bf16_t* P; const float* bias; const float* ssq;
    __device__ __forceinline__ bool reset(const Unit&) const { return true; }
    __device__ __forceinline__ void operator()(Acc& acc, const Unit& u, int wr, int wc, int fr, int fq) const {
        const int row0 = u.pm * BM + wr * 64 + fr, colt = u.pn * BM, n = colt >> 10;
        const int gb = (n == 0 ? C_GATE0 : (n == 1 ? C_GATE1 : C_GATE2)) + (colt & 1023);
        const int col0 = gb + wc * 32 + 8 * fq, bcol0 = colt + wc * 32 + 8 * fq;
        f32x4 bv[2][2];
#pragma unroll
        for (int bj = 0; bj < 2; ++bj)
#pragma unroll
            for (int nn = 0; nn < 2; ++nn) bv[bj][nn] = *(const f32x4*)(bias + bcol0 + bj * HALF + 4 * nn);
        float rsv[2][4];
#pragma unroll
        for (int ai = 0; ai < 2; ++ai)
#pragma unroll
            for (int m = 0; m < 4; ++m) rsv[ai][m] = ssq[row0 + ai * HALF + m * 16];
#pragma unroll
        for (int ai = 0; ai < 2; ++ai)
#pragma unroll
            for (int m = 0; m < 4; ++m) { bf16_t* rowp = P + (size_t)(row0 + ai * HALF + m * 16) * PLD + col0; const float rs = rsqrtf(rsv[ai][m] * (1.f / DM) + EPS);
#pragma unroll
                for (int bj = 0; bj < 2; ++bj) { f32x4 v0 = acc[ai][bj][m][0] * rs + bv[bj][0], v1 = acc[ai][bj][m][1] * rs + bv[bj][1];
#pragma unroll
                    for (int e = 0; e < 4; ++e) { v0[e] = fmaxf(sigmoidf_(v0[e]), 1e-30f); v1[e] = fmaxf(sigmoidf_(v1[e]), 1e-30f); }
                    u32x4 w; w.x = pk2(v0[0], v0[1]); w.y = pk2(v0[2], v0[3]); w.z = pk2(v1[0], v1[1]); w.w = pk2(v1[2], v1[3]);
                    *(u32x4*)(rowp + bj * HALF) = w; } }
    }
};
struct EpiBranch {
    const bf16_t* P; bf16_t* O;
    __device__ __forceinline__ bool reset(const Unit& u) const { return u.z == 2; }
    __device__ __forceinline__ void operator()(Acc& acc, const Unit& u, int wr, int wc, int fr, int fq) const {
        const int row0 = u.pm * BM + wr * 64 + fr, col0 = u.pn * BM + wc * 32 + 8 * fq;
        const int gz = (u.z == 0 ? C_GATE0 : (u.z == 1 ? C_GATE1 : C_GATE2)), gn = (u.z == 0 ? C_GATE1 : C_GATE2);
#pragma unroll
        for (int ai = 0; ai < 2; ++ai) {
            u32x4 ga[4][2], gb[4][2];
#pragma unroll
            for (int m = 0; m < 4; ++m) { const bf16_t* prow = P + (size_t)(row0 + ai * HALF + m * 16) * PLD + col0;
#pragma unroll
                for (int bj = 0; bj < 2; ++bj) { ga[m][bj] = *(const u32x4*)(prow + gz + bj * HALF); gb[m][bj] = (u.z < 2) ? *(const u32x4*)(prow + gn + bj * HALF) : ga[m][bj]; } }
#pragma unroll
            for (int m = 0; m < 4; ++m) { const int row = row0 + ai * HALF + m * 16;
#pragma unroll
                for (int bj = 0; bj < 2; ++bj) {
                    const u32x4 a = ga[m][bj], b = gb[m][bj];
                    float s[8] = {bflo(a.x), bfhi(a.x), bflo(a.y), bfhi(a.y), bflo(a.z), bfhi(a.z), bflo(a.w), bfhi(a.w)};
                    if (u.z < 2) { const float d[8] = {bflo(b.x), bfhi(b.x), bflo(b.y), bfhi(b.y), bflo(b.z), bfhi(b.z), bflo(b.w), bfhi(b.w)};
#pragma unroll
                        for (int e = 0; e < 8; ++e) s[e] = s[e] * __builtin_amdgcn_rcpf(d[e]); }
                    f32x4 v0 = acc[ai][bj][m][0], v1 = acc[ai][bj][m][1];
#pragma unroll
                    for (int e = 0; e < 4; ++e) { v0[e] *= s[e]; v1[e] *= s[4 + e]; }
                    acc[ai][bj][m][0] = v0; acc[ai][bj][m][1] = v1;
                    if (u.z == 2) { u32x4 w; w.x = pk2(v0[0], v0[1]); w.y = pk2(v0[2], v0[3]); w.z = pk2(v1[0], v1[1]); w.w = pk2(v1[2], v1[3]);
                        *(u32x4*)(O + (size_t)row * DM + col0 + bj * HALF) = w; }
                } }
        }
    }
};
struct EpiResid {
    const float* Xi; float* Xo; bf16_t* XB; float* ssq;
    __device__ __forceinline__ bool reset(const Unit&) const { return true; }
    __device__ __forceinline__ void operator()(Acc& acc, const Unit& u, int wr, int wc, int fr, int fq) const {
        const int row0 = u.pm * BM + wr * 64 + fr, col0 = u.pn * BM + wc * 32 + 8 * fq;
#pragma unroll
        for (int ai = 0; ai < 2; ++ai) {
            f32x4 xa[4][2], xb[4][2];
#pragma unroll
            for (int m = 0; m < 4; ++m) { const size_t off = (size_t)(row0 + ai * HALF + m * 16) * DM + col0;
#pragma unroll
                for (int bj = 0; bj < 2; ++bj) { xa[m][bj] = *(const f32x4*)(Xi + off + bj * HALF); xb[m][bj] = *(const f32x4*)(Xi + off + bj * HALF + 4); } }
#pragma unroll
            for (int m = 0; m < 4; ++m) { const size_t off = (size_t)(row0 + ai * HALF + m * 16) * DM + col0; float p = 0.f;
#pragma unroll
                for (int bj = 0; bj < 2; ++bj) {
                    const f32x4 x0 = xa[m][bj] + acc[ai][bj][m][0], x1 = xb[m][bj] + acc[ai][bj][m][1];
                    *(f32x4*)(Xo + off + bj * HALF) = x0; *(f32x4*)(Xo + off + bj * HALF + 4) = x1;
                    if (XB) { u32x4 w; w.x = pk2(x0[0], x0[1]); w.y = pk2(x0[2], x0[3]); w.z = pk2(x1[0], x1[1]); w.w = pk2(x1[2], x1[3]); *(u32x4*)(XB + off + bj * HALF) = w;
                        p += (x0[0] * x0[0] + x0[1] * x0[1]) + (x0[2] * x0[2] + x0[3] * x0[3]) + (x1[0] * x1[0] + x1[1] * x1[1]) + (x1[2] * x1[2] + x1[3] * x1[3]); } }
                if (XB) { p += __shfl_xor(p, 16); p += __shfl_xor(p, 32); if (fq == 0) atomicAdd(ssq + row0 + ai * HALF + m * 16, p); } }
        }
    }
};

template <class Epi, class Sched>
__device__ __forceinline__ void gemm_phase(LAS unsigned char* lds, const Gemm g, const Sched& S, const Epi& E) {
    int tid = threadIdx.x; asm volatile("" : "+v"(tid));
    const int wid = __builtin_amdgcn_readfirstlane(tid >> 6), lane = tid & 63, wr = wid >> 2, wc = wid & 3, fr = lane & 15, fq = lane >> 4;
    const int K = g.K, nt = K / BK, lda = g.lda;
    unsigned voffA[2], voffB[2];
#pragma unroll
    for (int i = 0; i < 2; ++i) { int R, C; stage_rc(tid * 16 + i * 8192, R, C); const int Rb = (R & ~31) + perm32(R & 31);
        voffA[i] = (unsigned)(R * lda + C) * 2u; voffB[i] = (unsigned)(Rb * K + C) * 2u; }
    const size_t kstep = (size_t)(BK * 2);
    const size_t hstepA = (size_t)HALF * lda * 2, hstepB = (size_t)HALF * K * 2;
    const size_t tstepA = 2 * hstepA, tstepB = 2 * hstepB;
    const unsigned ldsw = (unsigned)wid * 1024u;
    const int aoff = lds_byte(wr * 64 + fr, fq * 8), boff = lds_byte(wc * 32 + fr, fq * 8);
#define PG8_SA(b, h) (((b) * 2 + (h)) * HTB)
#define PG8_SB(b, h) ((4 + (b) * 2 + (h)) * HTB)
#define PG8_STAGE(bufoff, gbase, voff) do { _Pragma("unroll") for (int _i = 0; _i < 2; ++_i) \
        __builtin_amdgcn_global_load_lds((const unsigned*)((const char*)(gbase) + (voff)[_i]), (LAS unsigned*)(lds + (bufoff) + ldsw + _i * 8192), 16, 0, 0); } while (0)
#define PG8_LDA(dst, b, h) do { _Pragma("unroll") for (int m = 0; m < 4; ++m) _Pragma("unroll") for (int k = 0; k < 2; ++k) dst[m][k] = *(const LAS bf16x8*)(lds + PG8_SA(b, h) + aoff + m * 2048 + k * 1024); } while (0)
#define PG8_LDB(dst, b, h) do { _Pragma("unroll") for (int n = 0; n < 2; ++n) _Pragma("unroll") for (int k = 0; k < 2; ++k) dst[n][k] = *(const LAS bf16x8*)(lds + PG8_SB(b, h) + boff + n * 2048 + k * 1024); } while (0)
#define PG8_MMA(ai, bj, At, Bt) do { __builtin_amdgcn_s_setprio(1); _Pragma("unroll") for (int m = 0; m < 4; ++m) _Pragma("unroll") for (int n = 0; n < 2; ++n) _Pragma("unroll") for (int k = 0; k < 2; ++k) \
        acc[ai][bj][m][n] = __builtin_amdgcn_mfma_f32_16x16x32_bf16(Bt[n][k], At[m][k], acc[ai][bj][m][n], 0, 0, 0); __builtin_amdgcn_s_setprio(0); } while (0)
#define PG8_WAIT_V(n) asm volatile("s_waitcnt vmcnt(" #n ")" ::: "memory")
#define PG8_WAIT_L(n) asm volatile("s_waitcnt lgkmcnt(" #n ")" ::: "memory")
#define PG8_BAR __builtin_amdgcn_s_barrier()
#define PG8_SCHED __builtin_amdgcn_sched_barrier(0)
#define PG8_ZERO() do { _Pragma("unroll") for (int a = 0; a < 2; ++a) _Pragma("unroll") for (int b = 0; b < 2; ++b) _Pragma("unroll") for (int m = 0; m < 4; ++m) _Pragma("unroll") for (int n = 0; n < 2; ++n) acc[a][b][m][n] = (f32x4){0.f, 0.f, 0.f, 0.f}; } while (0)
    Unit cur, nxt; int ui = 0;
    if (!S.next(0, cur)) return;
    Acc acc;
    PG8_ZERO();
    bf16x8 At[4][2], B0[2][2], B1[2][2];
    const char* cA = (const char*)g.A + (size_t)cur.pm * tstepA + g.zA(cur.z); const char* cB = (const char*)g.Bt + (size_t)cur.pn * tstepB + (size_t)cur.z * g.zB;
    PG8_STAGE(PG8_SB(0, 0), cB, voffB); PG8_STAGE(PG8_SB(0, 1), cB + hstepB, voffB); PG8_STAGE(PG8_SA(0, 0), cA, voffA); PG8_STAGE(PG8_SA(0, 1), cA + hstepA, voffA);
    if (wr == 1) PG8_BAR;
    PG8_WAIT_V(2); PG8_BAR;
    PG8_STAGE(PG8_SB(1, 0), cB + kstep, voffB); PG8_STAGE(PG8_SA(1, 0), cA + kstep, voffA); PG8_STAGE(PG8_SB(1, 1), cB + hstepB + kstep, voffB);
    PG8_WAIT_V(6); PG8_BAR;
    for (;;) {
        const bool has_next = S.next(ui + 1, nxt);
        const char* nA = has_next ? (const char*)g.A + (size_t)nxt.pm * tstepA + g.zA(nxt.z) : cA;
        const char* nB = has_next ? (const char*)g.Bt + (size_t)nxt.pn * tstepB + (size_t)nxt.z * g.zB : cB;
        for (int t = 0; t < nt; t += 2) {
            const bool last = (t == nt - 2);
            const char* a1 = cA + (size_t)(t + 1) * kstep;
            const char* a2 = last ? nA : cA + (size_t)(t + 2) * kstep; const char* b2 = last ? nB : cB + (size_t)(t + 2) * kstep;
            const char* a3 = a2 + kstep; const char* b3 = b2 + kstep;
            PG8_LDB(B0, 0, 0); PG8_LDB(B1, 0, 1); PG8_SCHED; PG8_LDA(At, 0, 0); PG8_STAGE(PG8_SA(1, 1), a1 + hstepA, voffA);
            PG8_WAIT_V(8); PG8_WAIT_L(0); PG8_BAR; PG8_MMA(0, 0, At, B0); PG8_MMA(0, 1, At, B1); PG8_BAR; PG8_SCHED;
            PG8_LDA(At, 0, 1); PG8_STAGE(PG8_SB(0, 0), b2, voffB); PG8_STAGE(PG8_SB(0, 1), b2 + hstepB, voffB); PG8_STAGE(PG8_SA(0, 0), a2, voffA);
            PG8_WAIT_V(8); PG8_WAIT_L(0); PG8_BAR; PG8_MMA(1, 0, At, B0); PG8_MMA(1, 1, At, B1); PG8_BAR; PG8_SCHED;
            PG8_LDB(B0, 1, 0); PG8_LDB(B1, 1, 1); PG8_SCHED; PG8_LDA(At, 1, 0); PG8_STAGE(PG8_SA(0, 1), a2 + hstepA, voffA);
            PG8_WAIT_V(8); PG8_WAIT_L(0); PG8_BAR; PG8_MMA(0, 0, At, B0); PG8_MMA(0, 1, At, B1); PG8_BAR; PG8_SCHED;
            PG8_LDA(At, 1, 1); PG8_STAGE(PG8_SB(1, 0), b3, voffB); PG8_STAGE(PG8_SB(1, 1), b3 + hstepB, voffB); PG8_STAGE(PG8_SA(1, 0), a3, voffA);
            PG8_WAIT_V(8); PG8_WAIT_L(0); PG8_BAR; PG8_MMA(1, 0, At, B0); PG8_MMA(1, 1, At, B1); PG8_BAR; PG8_SCHED;
        }
        if (wr == 0) PG8_BAR;
        E(acc, cur, wr, wc, fr, fq);
        if (!has_next) break;
        if (E.reset(cur)) PG8_ZERO();
        cur = nxt; cA = nA; cB = nB; ++ui;
        if (wr == 1) PG8_BAR;
    }
    PG8_WAIT_V(0);
    PG8_BAR;
#undef PG8_SA
#undef PG8_SB
#undef PG8_STAGE
#undef PG8_LDA
#undef PG8_LDB
#undef PG8_MMA
#undef PG8_WAIT_V
#undef PG8_WAIT_L
#undef PG8_BAR
#undef PG8_SCHED
#undef PG8_ZERO
}
}

struct Args { const float* in[21]; float* out; unsigned char* ws; };

template <class RowMap>
__device__ __forceinline__ void transpose_weight(const float* W, int K, int N, const RowMap rm, LAS float* scr, int gw, int NGW, int lane, const float* gk = nullptr) {
    const int nblk = (N + 31) / 32, nitems = (K / 64) * nblk;
    for (int item = gw; item < nitems; item += NGW) {
        const int kb = item / nblk, nb = item % nblk, k0 = 64 * kb, n0 = 32 * nb;
        const int cn = n0 + (lane & 31);
#pragma unroll
        for (int i = 0; i < 32; ++i) { const int kk = 2 * i + (lane >> 5); scr[kk * 33 + (lane & 31)] = (cn < N) ? W[(size_t)(k0 + kk) * N + cn] * (gk ? gk[k0 + kk] : 1.f) : 0.f; }
        LDS_WAIT(); asm volatile("" ::: "memory");
        const int c = lane & 7;
#pragma unroll
        for (int j = 0; j < 4; ++j) { const int n = (lane >> 3) + 8 * j; const LAS float* s = scr + (8 * c) * 33 + n;
            u32x4 o; o.x = pk2(s[0 * 33], s[1 * 33]); o.y = pk2(s[2 * 33], s[3 * 33]); o.z = pk2(s[4 * 33], s[5 * 33]); o.w = pk2(s[6 * 33], s[7 * 33]);
            if (n0 + n < N) { bf16_t* dst = rm(n0 + n); *(u32x4*)(dst + k0 + 8 * c) = o; } }
        LDS_WAIT(); asm volatile("" ::: "memory");
    }
}
struct RmPlain { bf16_t* base; int K; __device__ __forceinline__ bf16_t* operator()(int n) const { return base + (size_t)n * K; } };
struct RmWin { bf16_t* win; bf16_t* wg; __device__ __forceinline__ bf16_t* operator()(int n) const { return n < NMIXCOL ? win + (size_t)n * DM : wg + (size_t)(n - NMIXCOL) * DM; } };
struct RmUp { bf16_t* base;
    __device__ __forceinline__ bf16_t* operator()(int n) const { const int isb = n >= FFH, j = isb ? n - FFH : n; return base + (size_t)(256 * (j >> 7) + (j & 127) + 128 * isb) * DM; } };

__device__ __forceinline__ void norm_rows_bf16(const float* X, const float* g, bf16_t* O, int gw, int NGW, int lane) {
    f32x4 gv[4];
#pragma unroll
    for (int j = 0; j < 4; ++j) gv[j] = *((const f32x4*)g + lane + 64 * j);
    for (int m = gw; m < T; m += NGW) {
        const f32x4* xr = (const f32x4*)(X + (size_t)m * DM) + lane;
        f32x4 v[4]; float s = 0.f;
#pragma unroll
        for (int j = 0; j < 4; ++j) { v[j] = xr[64 * j]; s += (v[j].x * v[j].x + v[j].y * v[j].y) + (v[j].z * v[j].z + v[j].w * v[j].w); }
        const float rstd = rsqrtf(wave_sum(s) * (1.f / DM) + EPS);
        u32x2* o8 = (u32x2*)(O + (size_t)m * DM) + lane;
#pragma unroll
        for (int j = 0; j < 4; ++j) { u32x2 w; w.x = pk2(v[j].x * rstd * gv[j].x, v[j].y * rstd * gv[j].y); w.y = pk2(v[j].z * rstd * gv[j].z, v[j].w * rstd * gv[j].w); o8[64 * j] = w; }
    }
}
__device__ __forceinline__ void conv_rows_bf16(const float* X, bf16_t* O, float* ssq, int gw, int NGW, int lane) {
    for (int m0 = 2 * gw; m0 < T; m0 += 2 * NGW) {
        f32x4 v[2][4];
#pragma unroll
        for (int k = 0; k < 2; ++k) { const f32x4* xr = (const f32x4*)(X + (size_t)(m0 + k) * DM) + lane;
#pragma unroll
            for (int j = 0; j < 4; ++j) v[k][j] = xr[64 * j]; }
#pragma unroll
        for (int k = 0; k < 2; ++k) { float s = 0.f;
            u32x2* o8 = (u32x2*)(O + (size_t)(m0 + k) * DM) + lane;
#pragma unroll
            for (int j = 0; j < 4; ++j) { const f32x4 x = v[k][j]; s += (x.x * x.x + x.y * x.y) + (x.z * x.z + x.w * x.w); u32x2 w; w.x = pk2(x.x, x.y); w.y = pk2(x.z, x.w); o8[64 * j] = w; }
            if (ssq) { s = wave_sum(s); if (lane == 0) ssq[m0 + k] = s; } }
    }
}
__device__ __forceinline__ void norm_rows_f32_inplace(float* X, const float* g, int gw, int NGW, int lane) {
    f32x4 gv[4];
#pragma unroll
    for (int j = 0; j < 4; ++j) gv[j] = *((const f32x4*)g + lane + 64 * j);
    for (int m0 = 2 * gw; m0 < T; m0 += 2 * NGW) {
        f32x4 v[2][4];
#pragma unroll
        for (int k = 0; k < 2; ++k) { const f32x4* xr = (const f32x4*)(X + (size_t)(m0 + k) * DM) + lane;
#pragma unroll
            for (int j = 0; j < 4; ++j) v[k][j] = xr[64 * j]; }
#pragma unroll
        for (int k = 0; k < 2; ++k) { float s = 0.f;
#pragma unroll
            for (int j = 0; j < 4; ++j) { const f32x4 x = v[k][j]; s += (x.x * x.x + x.y * x.y) + (x.z * x.z + x.w * x.w); }
            const float rstd = rsqrtf(wave_sum(s) * (1.f / DM) + EPS);
            f32x4* xw = (f32x4*)(X + (size_t)(m0 + k) * DM) + lane;
#pragma unroll
            for (int j = 0; j < 4; ++j) xw[64 * j] = v[k][j] * rstd * gv[j]; }
    }
}

__device__ __forceinline__ void hnorm_phase(bf16_t* proj, const bf16_t* odn, const float* g0, const float* g1, const float* g2, int gw, int NGW, int lane) {
    for (int it0 = 4 * gw; it0 < 3 * T; it0 += 4 * NGW) {
        u32x4 a[4], zz[4]; bf16_t* dst[4]; const float* gg[4];
#pragma unroll
        for (int k = 0; k < 4; ++k) {
            const int it = it0 + k, n = it % 3, t = it / 3;
            bf16_t* prow = proj + (size_t)t * PLD;
            const bf16_t* src = (n == 0) ? prow + C_HGI : (n == 1 ? prow + C_GLV : odn + (size_t)t * 512);
            const bf16_t* zsrc = prow + (n == 0 ? C_HGG : (n == 1 ? C_GLG : C_DNZ));
            dst[k] = prow + (n == 0 ? C_HGI : (n == 1 ? C_GLV : C_DNV));
            gg[k] = (n == 0 ? g0 : (n == 1 ? g1 : g2)) + (lane & 15) * 8;
            a[k] = *(const u32x4*)(src + lane * 8); zz[k] = *(const u32x4*)(zsrc + lane * 8);
        }
#pragma unroll
        for (int k = 0; k < 4; ++k) {
            float o[8] = {bflo(a[k].x), bfhi(a[k].x), bflo(a[k].y), bfhi(a[k].y), bflo(a[k].z), bfhi(a[k].z), bflo(a[k].w), bfhi(a[k].w)};
            const float z[8] = {bflo(zz[k].x), bfhi(zz[k].x), bflo(zz[k].y), bfhi(zz[k].y), bflo(zz[k].z), bfhi(zz[k].z), bflo(zz[k].w), bfhi(zz[k].w)};
            float s = 0.f;
#pragma unroll
            for (int e = 0; e < 8; ++e) s += o[e] * o[e];
            s = reduce16(s);
            const float rstd = rsqrtf(s * (1.f / 128.f) + EPS);
            const f32x4 ga = *(const f32x4*)gg[k], gb = *(const f32x4*)(gg[k] + 4);
            const float gv[8] = {ga.x, ga.y, ga.z, ga.w, gb.x, gb.y, gb.z, gb.w};
#pragma unroll
            for (int e = 0; e < 8; ++e) o[e] = o[e] * rstd * gv[e] * siluf_(z[e]);
            u32x4 w; w.x = pk2(o[0], o[1]); w.y = pk2(o[2], o[3]); w.z = pk2(o[4], o[5]); w.w = pk2(o[6], o[7]);
            *(u32x4*)(dst[k] + lane * 8) = w;
        }
    }
}

__device__ __forceinline__ void convgate_phase(const bf16_t* U, bf16_t* G, const float* cw, const float* cb, int gtid, int NT) {
    constexpr int RUN = 8, NJ = FFH / 8, NITEM = (TH / RUN) * NJ;
    for (int it = gtid; it < NITEM; it += NT) {
        const int jg = it % NJ, tr = it / NJ, j = jg * 8, t0 = tr * RUN;
        const int ca = 256 * (j >> 7) + (j & 127);
        const bool first = (t0 & (SEQ - 1)) == 0;
        const bf16_t* up = U + (size_t)t0 * UPN + ca;
        u32x4 ra[10], rb[10];
        if (!first) { ra[0] = *(const u32x4*)(up - 2 * (size_t)UPN); rb[0] = *(const u32x4*)(up - 2 * (size_t)UPN + 128); ra[1] = *(const u32x4*)(up - (size_t)UPN); rb[1] = *(const u32x4*)(up - (size_t)UPN + 128); }
        else { ra[0] = (u32x4){0, 0, 0, 0}; rb[0] = ra[0]; ra[1] = ra[0]; rb[1] = ra[0]; }
#pragma unroll
        for (int r = 0; r < 8; ++r) { ra[2 + r] = *(const u32x4*)(up + (size_t)r * UPN); rb[2 + r] = *(const u32x4*)(up + (size_t)r * UPN + 128); }
        float wa[3][8], wb[3][8], ba[8], bb[8];
#pragma unroll
        for (int k = 0; k < 3; ++k)
#pragma unroll
            for (int e = 0; e < 8; ++e) { wa[k][e] = cw[(size_t)k * UPN + j + e]; wb[k][e] = cw[(size_t)k * UPN + FFH + j + e]; }
#pragma unroll
        for (int e = 0; e < 8; ++e) { ba[e] = cb[j + e]; bb[e] = cb[FFH + j + e]; }
#pragma unroll
        for (int r = 0; r < 8; ++r) {
            const unsigned au[3][4] = {{ra[r].x, ra[r].y, ra[r].z, ra[r].w}, {ra[r + 1].x, ra[r + 1].y, ra[r + 1].z, ra[r + 1].w}, {ra[r + 2].x, ra[r + 2].y, ra[r + 2].z, ra[r + 2].w}};
            const unsigned bu[3][4] = {{rb[r].x, rb[r].y, rb[r].z, rb[r].w}, {rb[r + 1].x, rb[r + 1].y, rb[r + 1].z, rb[r + 1].w}, {rb[r + 2].x, rb[r + 2].y, rb[r + 2].z, rb[r + 2].w}};
            float o[8];
#pragma unroll
            for (int e = 0; e < 8; ++e) {
                float xa = ba[e], xb = bb[e];
#pragma unroll
                for (int k = 0; k < 3; ++k) { const float va = (e & 1) ? bfhi(au[k][e >> 1]) : bflo(au[k][e >> 1]); const float vb = (e & 1) ? bfhi(bu[k][e >> 1]) : bflo(bu[k][e >> 1]);
                    xa += wa[k][e] * va; xb += wb[k][e] * vb; }
                o[e] = siluf_(xa) * xb;
            }
            u32x4 w; w.x = pk2(o[0], o[1]); w.y = pk2(o[2], o[3]); w.z = pk2(o[4], o[5]); w.w = pk2(o[6], o[7]);
            *(u32x4*)(G + (size_t)(t0 + r) * FFH + j) = w;
        }
    }
}

constexpr int TB = 16;
constexpr int MIX_BUF_FLOATS = 3 * TB * 160 + TB * 64 + 2 * TB;
struct MixArgs { bf16_t* proj; bf16_t* odn; const bf16_t* halo; float* dec; const float* lbsrc; int layer; const float* w2; const float* gkb; const float* convw; const float* Alog; const float* dtb; };

template <int MIX>
__device__ __forceinline__ void mixer_chain(LAS unsigned char* lds, const MixArgs& A, int b, int h, int half) {
    constexpr int DK = (MIX == 1) ? 64 : 128, DS = DK / 8, DSP = (DS == 16) ? 20 : 8, ROW = 8 * DSP;
    int tid = threadIdx.x; asm volatile("" : "+v"(tid));
    const int lane = tid & 63, w = __builtin_amdgcn_readfirstlane(tid >> 6), ds = lane & 7, cgp = lane >> 3;
    LAS float* L = (LAS float*)lds;
    const size_t tbase = (size_t)b * SEQ;
    bf16_t* proj = A.proj;
    float c0 = 0.f, c1 = 0.f;
    float w2c[16]; float gb = 0.f;
    float wq[4][2], wk[4][2], wv[4][2]; float Aexp = 0.f, dtb = 0.f;
    if (MIX == 0) {
        if (A.layer == 1) { const float* p = A.lbsrc + h * 128 + 2 * lane; c0 = 1.f / (1.f + __expf(p[0] - p[512])); c1 = 1.f / (1.f + __expf(p[1] - p[513])); }
    } else if (MIX == 1) {
#pragma unroll
        for (int r = 0; r < 16; ++r) w2c[r] = A.w2[r * 256 + h * 64 + lane];
        gb = A.gkb[h * 64 + lane];
    } else {
#pragma unroll
        for (int j = 0; j < 4; ++j) {
            wq[j][0] = A.convw[j * 1536 + h * 128 + 2 * lane]; wq[j][1] = A.convw[j * 1536 + h * 128 + 2 * lane + 1];
            wk[j][0] = A.convw[j * 1536 + 512 + h * 128 + 2 * lane]; wk[j][1] = A.convw[j * 1536 + 512 + h * 128 + 2 * lane + 1];
            const int vc = 1024 + h * 128 + half * 64 + 2 * (lane & 31);
            wv[j][0] = A.convw[j * 1536 + vc]; wv[j][1] = A.convw[j * 1536 + vc + 1];
        }
        Aexp = __expf(A.Alog[h]); dtb = A.dtb[h];
    }
    unsigned rq[2][4], rk[2][4], rv[2][4], rs[2][2]; u32x4 rl[2][2];
    auto load_block = [&](int blk) {
#pragma unroll
        for (int i = 0; i < 2; ++i) {
            const int tin = blk * TB + 2 * w + i;
            const bf16_t* row = proj + (tbase + tin) * PLD;
            if (MIX == 0) {
                rq[i][0] = *(const unsigned*)(row + C_HGQ + h * 128 + 2 * lane);
                rk[i][0] = *(const unsigned*)(row + C_HGF + h * 128 + 2 * lane);
                rv[i][0] = *(const unsigned*)(row + C_HGI + h * 128 + half * 64 + 2 * (lane & 31));
            } else if (MIX == 1) {
                rq[i][0] = row[C_GLQ + h * 64 + lane]; rk[i][0] = row[C_GLK + h * 64 + lane];
                rv[i][0] = *(const unsigned*)(row + C_GLV + h * 128 + half * 64 + 2 * (lane & 31));
                rl[i][0] = *(const u32x4*)(row + C_GLGK); rl[i][1] = *(const u32x4*)(row + C_GLGK + 8);
            } else {
#pragma unroll
                for (int j = 0; j < 4; ++j) {
                    const int tt = tin - 3 + j;
                    if (tt >= 0) { const bf16_t* r2 = proj + (tbase + tt) * PLD;
                        rq[i][j] = *(const unsigned*)(r2 + C_DNQ + h * 128 + 2 * lane); rk[i][j] = *(const unsigned*)(r2 + C_DNK + h * 128 + 2 * lane);
                        rv[i][j] = *(const unsigned*)(r2 + C_DNV + h * 128 + half * 64 + 2 * (lane & 31)); }
                    else { rq[i][j] = 0u; rk[i][j] = 0u; rv[i][j] = 0u; }
                }
                rs[i][0] = row[C_DNB + h]; rs[i][1] = row[C_DNA + h];
            }
        }
    };
    auto store_block = [&](int buf) {
        LAS float* Q = L + buf * MIX_BUF_FLOATS; LAS float* Kp = Q + TB * 160; LAS float* F = Kp + TB * 160; LAS float* V = F + TB * 160; LAS float* SA = V + TB * 64; LAS float* SB = SA + TB;
#pragma unroll
        for (int i = 0; i < 2; ++i) {
            const int tok = 2 * w + i;
            if (MIX == 0) {
                const int d = 2 * lane, idx = tok * ROW + (d >> 4) * DSP + (d & 15);
                const float q0 = bflo(rq[i][0]), q1 = bfhi(rq[i][0]), z0 = bflo(rk[i][0]), z1 = bfhi(rk[i][0]);
                const float s0 = sigmoidf_(z0), s1 = sigmoidf_(z1);
                Q[idx] = siluf_(q0) * 0.08838834764831845f; Q[idx + 1] = siluf_(q1) * 0.08838834764831845f;
                F[idx] = c0 + (1.f - c0) * s0; F[idx + 1] = c1 + (1.f - c1) * s1;
                Kp[idx] = (1.f - c0) * (1.f - s0); Kp[idx + 1] = (1.f - c1) * (1.f - s1);
                if (lane < 32) { V[tok * 64 + 2 * lane] = bflo(rv[i][0]); V[tok * 64 + 2 * lane + 1] = bfhi(rv[i][0]); }
            } else if (MIX == 1) {
                const int idx = tok * ROW + lane;
                const unsigned lr[8] = {rl[i][0].x, rl[i][0].y, rl[i][0].z, rl[i][0].w, rl[i][1].x, rl[i][1].y, rl[i][1].z, rl[i][1].w};
                float gk = gb;
#pragma unroll
                for (int r = 0; r < 8; ++r) gk += bflo(lr[r]) * w2c[2 * r] + bfhi(lr[r]) * w2c[2 * r + 1];
                const float ls = fminf(gk, 0.f) - __logf(1.f + __expf(-fabsf(gk)));
                Q[idx] = bf1((bf16_t)rq[i][0]) * 0.125f; Kp[idx] = bf1((bf16_t)rk[i][0]); F[idx] = __expf(ls * (1.f / 16.f));
                if (lane < 32) { V[tok * 64 + 2 * lane] = bflo(rv[i][0]); V[tok * 64 + 2 * lane + 1] = bfhi(rv[i][0]); }
            } else {
                const int d = 2 * lane, idx = tok * ROW + (d >> 4) * DSP + (d & 15);
                float q0 = 0.f, q1 = 0.f, k0 = 0.f, k1 = 0.f, v0 = 0.f, v1 = 0.f;
#pragma unroll
                for (int j = 0; j < 4; ++j) { q0 += wq[j][0] * bflo(rq[i][j]); q1 += wq[j][1] * bfhi(rq[i][j]); k0 += wk[j][0] * bflo(rk[i][j]); k1 += wk[j][1] * bfhi(rk[i][j]);
                    v0 += wv[j][0] * bflo(rv[i][j]); v1 += wv[j][1] * bfhi(rv[i][j]); }
                q0 = siluf_(q0); q1 = siluf_(q1); k0 = siluf_(k0); k1 = siluf_(k1); v0 = siluf_(v0); v1 = siluf_(v1);
                const float nq = rsqrtf(wave_sum(q0 * q0 + q1 * q1) + EPS) * 0.08838834764831845f, nk = rsqrtf(wave_sum(k0 * k0 + k1 * k1) + EPS);
                Q[idx] = q0 * nq; Q[idx + 1] = q1 * nq; Kp[idx] = k0 * nk; Kp[idx + 1] = k1 * nk;
                if (lane < 32) { V[tok * 64 + 2 * lane] = v0; V[tok * 64 + 2 * lane + 1] = v1; }
                if (lane == 0) { const float be = sigmoidf_(bf1((bf16_t)rs[i][0])); const float gg = -Aexp * softplusf_(bf1((bf16_t)rs[i][1]) + dtb);
                    SA[tok] = __expf(gg); SB[tok] = be; }
            }
        }
    };
    float S[DS];
#pragma unroll
    for (int i = 0; i < DS; ++i) S[i] = 0.f;
    const int col = half * 64 + w * 8 + cgp;
    bf16_t* obase = (MIX == 0) ? proj + tbase * PLD + C_HGI + h * 128 + col : (MIX == 1 ? proj + tbase * PLD + C_GLV + h * 128 + col : A.odn + tbase * 512 + h * 128 + col);
    const size_t opitch = (MIX == 2) ? 512 : PLD;
    constexpr int NBLK = SEQ / TB;
    load_block(0);
    for (int blk = 0; blk < NBLK; ++blk) {
        const int buf = blk & 1;
        store_block(buf);
        __syncthreads();
        if (blk + 1 < NBLK) load_block(blk + 1);
        const LAS float* Q = L + buf * MIX_BUF_FLOATS; const LAS float* Kp = Q + TB * 160; const LAS float* F = Kp + TB * 160; const LAS float* V = F + TB * 160; const LAS float* SA = V + TB * 64; const LAS float* SB = SA + TB;
#pragma unroll 2
        for (int tok = 0; tok < TB; ++tok) {
            const int o0 = tok * ROW + ds * DSP;
            float qv[DS], kv[DS], fv[DS];
#pragma unroll
            for (int i = 0; i < DS; i += 4) { const f32x4 a = *(const LAS f32x4*)(Q + o0 + i), c = *(const LAS f32x4*)(Kp + o0 + i);
                qv[i] = a.x; qv[i + 1] = a.y; qv[i + 2] = a.z; qv[i + 3] = a.w; kv[i] = c.x; kv[i + 1] = c.y; kv[i + 2] = c.z; kv[i + 3] = c.w; }
            const float v = V[tok * 64 + w * 8 + cgp];
            float po = 0.f;
            if (MIX != 2) {
#pragma unroll
                for (int i = 0; i < DS; i += 4) { const f32x4 a = *(const LAS f32x4*)(F + o0 + i); fv[i] = a.x; fv[i + 1] = a.y; fv[i + 2] = a.z; fv[i + 3] = a.w; }
#pragma unroll
                for (int i = 0; i < DS; ++i) { S[i] = fv[i] * S[i] + kv[i] * v; po += S[i] * qv[i]; }
            } else {
                float pk0 = 0.f, pk1 = 0.f;
#pragma unroll
                for (int i = 0; i < DS; i += 2) { pk0 += kv[i] * S[i]; pk1 += kv[i + 1] * S[i + 1]; }
                const float kS = reduce8(pk0 + pk1);
                const float a = SA[tok], be = SB[tok];
                const float delta = be * (v - a * kS);
#pragma unroll
                for (int i = 0; i < DS; ++i) { S[i] = a * S[i] + kv[i] * delta; po += S[i] * qv[i]; }
            }
            const float o = reduce8(po);
            if (ds == 0) obase[(size_t)(blk * TB + tok) * opitch] = (bf16_t)f2bf(o);
        }
    }
    __syncthreads();
}

constexpr size_t AUX_SLOT = 32 * MiB;
constexpr int NCHUNK = SEQ / 64;
#define MFMA16(a, b, c) __builtin_amdgcn_mfma_f32_16x16x32_bf16((a), (b), (c), 0, 0, 0)
__device__ __forceinline__ bf16x8 ldsfrag(const LAS bf16_t* p) { return *(const LAS bf16x8*)p; }
__device__ __forceinline__ float logsigmoidf_(float x) { return fminf(x, 0.f) - __logf(1.f + __expf(-fabsf(x))); }

template <int MIX> __device__ __forceinline__ void gla_elem(float rq, float rz, float lb, float gk, float& q, float& k, float& f) {
    if (MIX == 0) { const float s = sigmoidf_(rz); q = siluf_(rq) * 0.08838834764831845f; f = lb + (1.f - lb) * s; k = (1.f - lb) * (1.f - s); }
    else { q = rq * 0.125f; k = rz; f = __expf(logsigmoidf_(gk) * (1.f / 16.f)); }
}

template <int MIX>
__device__ __forceinline__ void prep_gla_item(LAS unsigned char* lds, const MixArgs& A, int b, int h, int n, bf16_t* Aout) {
    constexpr int DK = (MIX == 1) ? 64 : 128, DS = DK / 8, DKR = DK + 4, BS = DK + 8;
    int tid = threadIdx.x; asm volatile("" : "+v"(tid));
    const int lane = tid & 63, w = __builtin_amdgcn_readfirstlane(tid >> 6), r = lane & 15, quad = lane >> 4;
    LAS float* F = (LAS float*)lds; LAS float* DT = F + 64 * DKR;
    LAS bf16_t* QPb = (LAS bf16_t*)(DT + 4 * DK); LAS bf16_t* KPb = QPb + 64 * BS; LAS bf16_t* QT = KPb + 64 * BS; LAS bf16_t* KL = QT + 64 * BS; LAS bf16_t* KS = KL + 64 * BS; LAS bf16_t* AO = KS + 48 * BS;
    const bf16_t* prow = A.proj + ((size_t)b * SEQ + (size_t)n * 64) * PLD;
    const int d = tid % DK, blk = tid / DK;
    float kls[16], qlp[16];
    if (blk < 4) {
        float lb = 0.f, gb = 0.f, w2c[16];
        if (MIX == 0) { if (A.layer == 1) { const float* p = A.lbsrc + h * 128 + d; lb = 1.f / (1.f + __expf(p[0] - p[512])); } }
        else {
#pragma unroll
            for (int rr = 0; rr < 16; ++rr) w2c[rr] = A.w2[rr * 256 + h * 64 + d];
            gb = A.gkb[h * 64 + d];
        }
        unsigned short rq_[16], rz_[16];
#pragma unroll
        for (int i = 0; i < 16; ++i) { const bf16_t* row = prow + (size_t)(blk * 16 + i) * PLD;
            if (MIX == 0) { rq_[i] = row[C_HGQ + h * 128 + d]; rz_[i] = row[C_HGF + h * 128 + d]; }
            else { rq_[i] = row[C_GLQ + h * 64 + d]; rz_[i] = row[C_GLK + h * 64 + d]; } }
        float f[16], qp[16], kp[16];
#pragma unroll
        for (int i = 0; i < 16; ++i) {
            float gk = gb;
            if (MIX == 1) { const bf16_t* row = prow + (size_t)(blk * 16 + i) * PLD; const u32x4 l0 = *(const u32x4*)(row + C_GLGK), l1 = *(const u32x4*)(row + C_GLGK + 8);
                const unsigned lr[8] = {l0.x, l0.y, l0.z, l0.w, l1.x, l1.y, l1.z, l1.w};
#pragma unroll
                for (int rr = 0; rr < 8; ++rr) gk += bflo(lr[rr]) * w2c[2 * rr] + bfhi(lr[rr]) * w2c[2 * rr + 1]; }
            gla_elem<MIX>(bf1(rq_[i]), bf1(rz_[i]), lb, gk, qp[i], kp[i], f[i]);
        }
        float lp = 1.f;
#pragma unroll
        for (int i = 0; i < 16; ++i) { const int t = blk * 16 + i; lp *= f[i];
            qlp[i] = qp[i] * lp; F[t * DKR + d] = f[i]; QPb[t * BS + d] = (bf16_t)f2bf(qp[i]); KPb[t * BS + d] = (bf16_t)f2bf(kp[i]); QT[t * BS + d] = (bf16_t)f2bf(qlp[i]); }
        DT[blk * DK + d] = lp;
        float ls = 1.f;
#pragma unroll
        for (int i = 15; i >= 0; --i) { kls[i] = kp[i] * ls; KL[(blk * 16 + i) * BS + d] = (bf16_t)f2bf(kls[i]); ls *= f[i]; }
    }
    for (int i = tid; i < 64 * 64 / 4; i += 512) ((LAS u32x2*)AO)[i] = (u32x2){0u, 0u};
    LDS_BARRIER();
    if (blk < 4) {
        const float d0 = DT[0 * DK + d], d1 = DT[1 * DK + d], d2 = DT[2 * DK + d], d3 = DT[3 * DK + d];
        const float pprev = (blk == 0) ? 1.f : (blk == 1 ? d0 : (blk == 2 ? d0 * d1 : d0 * d1 * d2)), pnext = (blk == 3) ? 1.f : (blk == 2 ? d3 : (blk == 1 ? d2 * d3 : d1 * d2 * d3));
        bf16_t* grow = A.proj + ((size_t)b * SEQ + (size_t)n * 64) * PLD;
        const int cq = (MIX == 0 ? C_HGQ + h * 128 : C_GLQ + h * 64) + d;
#pragma unroll
        for (int i = 0; i < 16; ++i) grow[(size_t)(blk * 16 + i) * PLD + cq] = (bf16_t)f2bf(qlp[i] * pprev);
        bf16_t* kdst = (MIX == 0) ? grow + (size_t)(d >> 1) * PLD + C_HGF + h * 128 + (d & 1) * 64 + blk * 16 : grow + (size_t)d * PLD + C_GLK + h * 64 + blk * 16;
        u32x4 o0, o1;
        o0.x = pk2(kls[0] * pnext, kls[1] * pnext); o0.y = pk2(kls[2] * pnext, kls[3] * pnext); o0.z = pk2(kls[4] * pnext, kls[5] * pnext); o0.w = pk2(kls[6] * pnext, kls[7] * pnext);
        o1.x = pk2(kls[8] * pnext, kls[9] * pnext); o1.y = pk2(kls[10] * pnext, kls[11] * pnext); o1.z = pk2(kls[12] * pnext, kls[13] * pnext); o1.w = pk2(kls[14] * pnext, kls[15] * pnext);
        *(u32x4*)kdst = o0; *(u32x4*)(kdst + 8) = o1;
        if (blk == 0) A.dec[(MIX == 0 ? (size_t)0 : DEC_GLA_OFF / 4) + ((size_t)(b * 4 + h) * NCHUNK + n) * DK + d] = d0 * d1 * d2 * d3;
    }
    if (blk < 2) {
        const float d1 = DT[1 * DK + d], d2 = DT[2 * DK + d];
#pragma unroll
        for (int i = 0; i < 16; ++i) {
            if (blk == 0) { KS[(0 * 16 + i) * BS + d] = (bf16_t)f2bf(kls[i] * d1); KS[(2 * 16 + i) * BS + d] = (bf16_t)f2bf(kls[i] * d1 * d2); }
            else KS[(1 * 16 + i) * BS + d] = (bf16_t)f2bf(kls[i] * d2);
        }
    }
    LDS_BARRIER();
    if (w < 6) {
        const int bi = (w == 0) ? 1 : ((w == 1 || w == 3) ? 2 : 3), bj = (w < 3) ? w : ((w == 3) ? 0 : (w == 4 ? 1 : 0));
        const LAS bf16_t* Kt = (w < 3) ? KL + (16 * bj) * BS : KS + (16 * (w - 3)) * BS;
        f32x4 acc = {0.f, 0.f, 0.f, 0.f};
#pragma unroll
        for (int kk = 0; kk < DK / 32; ++kk) acc = MFMA16(ldsfrag(Kt + r * BS + 32 * kk + quad * 8), ldsfrag(QT + (16 * bi + r) * BS + 32 * kk + quad * 8), acc);
        u32x2 o; o.x = pk2(acc[0], acc[1]); o.y = pk2(acc[2], acc[3]);
        *(LAS u32x2*)(AO + (16 * bi + r) * 64 + 16 * bj + quad * 4) = o;
    }
    {
        const int gi = (w < 4) ? 2 * w : 2 * (w - 4) + 1;
        const int s = 8 * gi + (lane >> 3), ds = lane & 7, tend = (s | 15) + 1;
        float p[DS];
#pragma unroll
        for (int i = 0; i < DS; i += 8) { const bf16x8 kk8 = ldsfrag(KPb + s * BS + ds * DS + i);
#pragma unroll
            for (int e = 0; e < 8; ++e) p[i + e] = bf1((bf16_t)kk8[e]); }
        float fv[DS], qv[DS];
#define MARCH_LOAD(t_) do { _Pragma("unroll") for (int i = 0; i < DS; i += 4) { const f32x4 a = *(const LAS f32x4*)(F + (t_) * DKR + ds * DS + i); fv[i] = a.x; fv[i + 1] = a.y; fv[i + 2] = a.z; fv[i + 3] = a.w; } \
            _Pragma("unroll") for (int i = 0; i < DS; i += 8) { const bf16x8 q8 = ldsfrag(QPb + (t_) * BS + ds * DS + i); _Pragma("unroll") for (int e = 0; e < 8; ++e) qv[i + e] = bf1((bf16_t)q8[e]); } } while (0)
        MARCH_LOAD(8 * gi);
        for (int t = 8 * gi; t < tend; ++t) {
            float fc[DS], qc[DS];
#pragma unroll
            for (int i = 0; i < DS; ++i) { fc[i] = fv[i]; qc[i] = qv[i]; }
            { const int tn = (t + 1 < 64) ? t + 1 : t; MARCH_LOAD(tn); }
            const bool adv = t > s;
            float a0 = 0.f, a1 = 0.f;
#pragma unroll
            for (int i = 0; i < DS; i += 2) { p[i] = adv ? p[i] * fc[i] : p[i]; p[i + 1] = adv ? p[i + 1] * fc[i + 1] : p[i + 1]; a0 += p[i] * qc[i]; a1 += p[i + 1] * qc[i + 1]; }
            const float tot = reduce8(a0 + a1);
            if (ds == 0 && t >= s) AO[t * 64 + s] = (bf16_t)f2bf(tot);
        }
#undef MARCH_LOAD
    }
    LDS_BARRIER();
    *(u32x4*)(Aout + tid * 8) = *(const LAS u32x4*)(AO + tid * 8);
    LDS_BARRIER();
}

struct DnConv { float wq[4][2], wk[4][2]; };
__device__ __forceinline__ void dn_load_conv(DnConv& c, const float* convw, int h, int lane) {
#pragma unroll
    for (int j = 0; j < 4; ++j) { c.wq[j][0] = convw[j * 1536 + h * 128 + 2 * lane]; c.wq[j][1] = convw[j * 1536 + h * 128 + 2 * lane + 1];
        c.wk[j][0] = convw[j * 1536 + 512 + h * 128 + 2 * lane]; c.wk[j][1] = convw[j * 1536 + 512 + h * 128 + 2 * lane + 1]; }
}
struct DnRaw { unsigned q[11], k[11]; };
__device__ __forceinline__ void dn_load_rows(DnRaw& R, const bf16_t* seqrow, const bf16_t* hrow, int cbase, int tin0, int h, int lane) {
#pragma unroll
    for (int i = 0; i < 11; ++i) { const int tt = tin0 - 3 + i;
        if (tt >= cbase) { const bf16_t* r2 = seqrow + (size_t)tt * PLD; R.q[i] = *(const unsigned*)(r2 + C_DNQ + h * 128 + 2 * lane); R.k[i] = *(const unsigned*)(r2 + C_DNK + h * 128 + 2 * lane); }
        else if (hrow) { const bf16_t* r2 = hrow + (size_t)(tt - (cbase - 3)) * HALO_LD - HALO_C0; R.q[i] = *(const unsigned*)(r2 + C_DNQ + h * 128 + 2 * lane); R.k[i] = *(const unsigned*)(r2 + C_DNK + h * 128 + 2 * lane); }
        else { R.q[i] = 0u; R.k[i] = 0u; } }
}
template <int I> __device__ __forceinline__ void dn_qk_token(const DnConv& c, const DnRaw& R, float& q0, float& q1, float& k0, float& k1) {
    q0 = q1 = k0 = k1 = 0.f;
#pragma unroll
    for (int j = 0; j < 4; ++j) { const unsigned uq = R.q[I + j], uk = R.k[I + j];
        q0 += c.wq[j][0] * bflo(uq); q1 += c.wq[j][1] * bfhi(uq); k0 += c.wk[j][0] * bflo(uk); k1 += c.wk[j][1] * bfhi(uk); }
    q0 = siluf_(q0); q1 = siluf_(q1); k0 = siluf_(k0); k1 = siluf_(k1);
    const float nq = __builtin_amdgcn_rsqf(wave_sum(q0 * q0 + q1 * q1) + EPS) * 0.08838834764831845f, nk = __builtin_amdgcn_rsqf(wave_sum(k0 * k0 + k1 * k1) + EPS);
    q0 *= nq; q1 *= nq; k0 *= nk; k1 *= nk;
}
__device__ __forceinline__ void dn_gates(bf16_t rb, bf16_t ra, int lane, float Aexp, float dtb, float& beta, float& G) {
    beta = sigmoidf_(bf1(rb));
    float g = -Aexp * softplusf_(bf1(ra) + dtb);
#pragma unroll
    for (int o = 1; o < 64; o <<= 1) { const float u = __shfl_up(g, o); if (lane >= o) g += u; }
    G = g;
}

__device__ __forceinline__ void prep_gdn_item(LAS unsigned char* lds, const MixArgs& A, int b, int h, int n, bf16_t* Tout, bf16_t* SCout) {
    constexpr int QS = 136, MS = 68;
    int tid = threadIdx.x; asm volatile("" : "+v"(tid));
    const int lane = tid & 63, w = __builtin_amdgcn_readfirstlane(tid >> 6), r = lane & 15, quad = lane >> 4;
    LAS bf16_t* QH = (LAS bf16_t*)lds; LAS bf16_t* KH = QH + 64 * QS; LAS float* MM = (LAS float*)(KH + 64 * QS); LAS bf16_t* TB16 = (LAS bf16_t*)(MM + 64 * MS);
    const bf16_t* seqrow = A.proj + (size_t)b * SEQ * PLD;
    const bf16_t* crow = seqrow + (size_t)n * 64 * PLD;
    float beta, G;
    const bf16_t* hrow = n > 0 ? A.halo + (size_t)(b * NCHUNK + n - 1) * 3 * HALO_LD : nullptr;
    {   DnRaw R; dn_load_rows(R, seqrow, hrow, n * 64, n * 64 + 8 * w, h, lane);
        const bf16_t rb = crow[(size_t)lane * PLD + C_DNB + h], ra = crow[(size_t)lane * PLD + C_DNA + h];
        const int vcol = tid & 127, vtg = tid >> 7;
        unsigned short rvv[19];
#pragma unroll
        for (int i = 0; i < 19; ++i) { const int tt = vtg * 16 - 3 + i;
            rvv[i] = (tt >= 0) ? crow[(size_t)tt * PLD + C_DNV + h * 128 + vcol] : (hrow ? hrow[(size_t)(tt + 3) * HALO_LD + (C_DNV - HALO_C0) + h * 128 + vcol] : (unsigned short)0); }
        float wv4[4];
#pragma unroll
        for (int j = 0; j < 4; ++j) wv4[j] = A.convw[j * 1536 + 1024 + h * 128 + vcol];
        DnConv c; dn_load_conv(c, A.convw, h, lane);
        dn_gates(rb, ra, lane, __expf(A.Alog[h]), A.dtb[h], beta, G);
#define PREP_TOK(I) { const int t = 8 * w + I; float q0, q1, k0, k1; dn_qk_token<I>(c, R, q0, q1, k0, k1); \
            *(LAS unsigned*)(QH + t * QS + 2 * lane) = pk2(q0, q1); *(LAS unsigned*)(KH + t * QS + 2 * lane) = pk2(k0, k1); }
        PREP_TOK(0) PREP_TOK(1) PREP_TOK(2) PREP_TOK(3) PREP_TOK(4) PREP_TOK(5) PREP_TOK(6) PREP_TOK(7)
#undef PREP_TOK
        bf16_t* od = A.odn + ((size_t)b * SEQ + (size_t)n * 64 + vtg * 16) * 512 + h * 128 + vcol;
#pragma unroll
        for (int i = 0; i < 16; ++i) { const float x = wv4[0] * bf1(rvv[i]) + wv4[1] * bf1(rvv[i + 1]) + wv4[2] * bf1(rvv[i + 2]) + wv4[3] * bf1(rvv[i + 3]);
            od[(size_t)i * 512] = (bf16_t)f2bf(siluf_(x) * __shfl(beta, vtg * 16 + i)); }
        { const float g63 = __shfl(G, 63); if (tid == 0) A.dec[DEC_GDN_OFF / 4 + (size_t)(b * 4 + h) * NCHUNK + n] = __expf(g63); }
    }
    LDS_BARRIER();
    {
        bf16_t* grow = A.proj + ((size_t)b * SEQ + (size_t)n * 64) * PLD;
        {   const int t = tid >> 3, sg = tid & 7; const float Gt = __shfl(G, t), eg = __expf(Gt), bg = __shfl(beta, t) * eg;
            bf16_t* drow = grow + (size_t)t * PLD + h * 128 + sg * 16;
#pragma unroll
            for (int hh = 0; hh < 2; ++hh) {
                const bf16x8 q8 = ldsfrag(QH + t * QS + sg * 16 + hh * 8), k8 = ldsfrag(KH + t * QS + sg * 16 + hh * 8);
                u32x4 oq, ok;
                oq.x = pk2(bf1((bf16_t)q8[0]) * eg, bf1((bf16_t)q8[1]) * eg); oq.y = pk2(bf1((bf16_t)q8[2]) * eg, bf1((bf16_t)q8[3]) * eg); oq.z = pk2(bf1((bf16_t)q8[4]) * eg, bf1((bf16_t)q8[5]) * eg); oq.w = pk2(bf1((bf16_t)q8[6]) * eg, bf1((bf16_t)q8[7]) * eg);
                ok.x = pk2(bf1((bf16_t)k8[0]) * bg, bf1((bf16_t)k8[1]) * bg); ok.y = pk2(bf1((bf16_t)k8[2]) * bg, bf1((bf16_t)k8[3]) * bg); ok.z = pk2(bf1((bf16_t)k8[4]) * bg, bf1((bf16_t)k8[5]) * bg); ok.w = pk2(bf1((bf16_t)k8[6]) * bg, bf1((bf16_t)k8[7]) * bg);
                *(u32x4*)(drow + C_DNQ + hh * 8) = oq; *(u32x4*)(drow + C_DNK + hh * 8) = ok; }
        }
        {   const int dd = tid & 127, sq = w >> 1; const float G63 = __shfl(G, 63);
            float kd[16];
#pragma unroll
            for (int i = 0; i < 16; ++i) { const int ss = sq * 16 + i; kd[i] = bf1(KH[ss * QS + dd]) * __expf(G63 - __shfl(G, ss)); }
            bf16_t* kdst = grow + (size_t)(dd >> 1) * PLD + C_DNV + h * 128 + (dd & 1) * 64 + sq * 16;
            u32x4 o0, o1;
            o0.x = pk2(kd[0], kd[1]); o0.y = pk2(kd[2], kd[3]); o0.z = pk2(kd[4], kd[5]); o0.w = pk2(kd[6], kd[7]);
            o1.x = pk2(kd[8], kd[9]); o1.y = pk2(kd[10], kd[11]); o1.z = pk2(kd[12], kd[13]); o1.w = pk2(kd[14], kd[15]);
            *(u32x4*)kdst = o0; *(u32x4*)(kdst + 8) = o1;
        }
    }
#pragma unroll
    for (int q = 0; q < 4; ++q) {
        const int tile = 4 * w + q, isq = tile >> 4, tm = (tile >> 2) & 3, tn = tile & 3;
        const LAS bf16_t* X = isq ? QH : KH;
        f32x4 acc = {0.f, 0.f, 0.f, 0.f};
#pragma unroll
        for (int kk = 0; kk < 4; ++kk) acc = MFMA16(ldsfrag(KH + (16 * tm + r) * QS + 32 * kk + quad * 8), ldsfrag(X + (16 * tn + r) * QS + 32 * kk + quad * 8), acc);
        const int t = 16 * tn + r, s0 = 16 * tm + quad * 4;
        const float Gt = __shfl(G, t), bt = __shfl(beta, t);
        float v[4];
#pragma unroll
        for (int j = 0; j < 4; ++j) { const int s = s0 + j; const float Gs = __shfl(G, s); const float L = __expf(fminf(Gt - Gs, 0.f));
            v[j] = isq ? ((s <= t) ? acc[j] * L : 0.f) : ((s < t) ? acc[j] * L * bt : 0.f); }
        if (isq) { u32x2 o; o.x = pk2(v[0], v[1]); o.y = pk2(v[2], v[3]); *(u32x2*)(SCout + t * 64 + s0) = o; }
        else *(LAS f32x4*)(MM + t * MS + s0) = (f32x4){v[0], v[1], v[2], v[3]};
    }
    LDS_BARRIER();
    {
        const int col = tid >> 3, ds = tid & 7;
        float xs[8];
#pragma unroll
        for (int i = 0; i < 8; ++i) xs[i] = 0.f;
#pragma unroll
        for (int rb = 0; rb < 8; ++rb) {
            float mm[8][8];
#pragma unroll
            for (int j = 0; j < 8; ++j)
#pragma unroll
                for (int i = 0; i <= rb; ++i) mm[j][i] = MM[(8 * rb + j) * MS + 8 * i + ds];
#pragma unroll
            for (int j = 0; j < 8; ++j) {
                const int t = 8 * rb + j;
                float part = 0.f;
#pragma unroll
                for (int i = 0; i <= rb; ++i) part += mm[j][i] * xs[i];
                const float xt = ((t == col) ? 1.f : 0.f) - reduce8(part);
                if (ds == j) xs[rb] = xt;
            }
        }
#pragma unroll
        for (int i = 0; i < 8; ++i) TB16[(8 * i + ds) * 64 + col] = (bf16_t)f2bf(xs[i]);
    }
    LDS_BARRIER();
    *(u32x4*)(Tout + tid * 8) = *(const LAS u32x4*)(TB16 + tid * 8);
    LDS_BARRIER();
}

template <int MIX, int DRYRUN = 0>
__device__ __forceinline__ void chain_gla(LAS unsigned char* lds, const MixArgs& A, int b, int h, int half, const bf16_t* Aaux) {
    constexpr int DK = (MIX == 1) ? 64 : 128, QS = DK + 8, TS = 72, NST = DK / 32, NP = DK / 64;
    int tid = threadIdx.x; asm volatile("" : "+v"(tid));
    const int lane = tid & 63, w = __builtin_amdgcn_readfirstlane(tid >> 6), r = lane & 15, quad = lane >> 4;
    LAS bf16_t* QD = (LAS bf16_t*)lds; LAS bf16_t* KDT = QD + 64 * QS; LAS bf16_t* VT = KDT + DK * TS; LAS bf16_t* ST = VT + 64 * TS;
    LAS float* DEC = (LAS float*)(ST + 64 * QS); LAS bf16_t* AL = (LAS bf16_t*)(DEC + DK); LAS bf16_t* OST = AL + 64 * TS + w * 512;
    const int vc = tid & 63, vg = tid >> 6;
    bf16_t* pbase = A.proj + (size_t)b * SEQ * PLD;
    const int cq0 = (MIX == 0 ? C_HGQ + h * 128 : C_GLQ + h * 64), ck0 = (MIX == 0 ? C_HGF + h * 128 : C_GLK + h * 64), cv = (MIX == 0 ? C_HGI : C_GLV) + h * 128 + half * 64;
    const float* decg = A.dec + (MIX == 0 ? (size_t)0 : DEC_GLA_OFF / 4) + (size_t)(b * 4 + h) * NCHUNK * DK;
    const int tr = w >> 1, tc0 = 2 * (w & 1);
    int sdt[NST], sct[NST];
#pragma unroll
    for (int q = 0; q < NST; ++q) { if (DK == 128) { sdt[q] = w; sct[q] = q; } else { sdt[q] = w >> 1; sct[q] = 2 * (w & 1) + q; } }
    f32x4 Sacc[NST];
#pragma unroll
    for (int q = 0; q < NST; ++q) Sacc[q] = (f32x4){0.f, 0.f, 0.f, 0.f};
    for (int i = tid; i < 64 * QS / 2; i += 512) ((LAS unsigned*)ST)[i] = 0u;
    struct Pre { u32x4 qd[NP], kd[NP], am; unsigned short v[8]; float dec; };
    Pre P0, P1; P0.dec = 0.f; P1.dec = 0.f;
#define GLA_LOAD(P, n_) do { const bf16_t* cr = pbase + (size_t)(n_) * 64 * PLD; \
        _Pragma("unroll") for (int k = 0; k < NP; ++k) { const int p = tid + 512 * k; \
            P.qd[k] = *(const u32x4*)(cr + (size_t)(p / (DK / 8)) * PLD + cq0 + (p % (DK / 8)) * 8); \
            P.kd[k] = *(const u32x4*)(cr + (size_t)(p / (DK / 8)) * PLD + ck0 + (p % (DK / 8)) * 8); } \
        _Pragma("unroll") for (int i = 0; i < 8; ++i) P.v[i] = cr[(size_t)(vg * 8 + i) * PLD + cv + vc]; \
        if (tid < DK) P.dec = decg[(size_t)(n_) * DK + tid]; \
        P.am = *(const u32x4*)(Aaux + (size_t)(n_) * 4096 + tid * 8); } while (0)
    GLA_LOAD(P0, 0); GLA_LOAD(P1, 1);
#define GLA_CHUNK(P, n) do { \
        *(LAS u32x4*)(AL + (tid >> 3) * TS + (tid & 7) * 8) = P.am; \
        _Pragma("unroll") for (int k = 0; k < NP; ++k) { const int p = tid + 512 * k, row = p / (DK / 8), seg = p % (DK / 8); \
            *(LAS u32x4*)(QD + row * QS + seg * 8) = P.qd[k]; \
            const int dd = (DK == 128) ? 2 * row + (seg >> 3) : row, ss = (seg & 7) * 8; \
            *(LAS u32x4*)(KDT + dd * TS + ss) = P.kd[k]; } \
        if (tid < DK) DEC[tid] = P.dec; \
        { u32x4 o; o.x = (unsigned)P.v[0] | ((unsigned)P.v[1] << 16); o.y = (unsigned)P.v[2] | ((unsigned)P.v[3] << 16); o.z = (unsigned)P.v[4] | ((unsigned)P.v[5] << 16); o.w = (unsigned)P.v[6] | ((unsigned)P.v[7] << 16); \
          *(LAS u32x4*)(VT + vc * TS + vg * 8) = o; } \
        { const int nn = ((n) + 2 < NCHUNK) ? (n) + 2 : NCHUNK - 1; GLA_LOAD(P, nn); } \
        gla_body((n)); } while (0)
    auto gla_body = [&](int n) __attribute__((always_inline)) {
        LDS_BARRIER();
        bf16x8 fa[DK / 32], fs[2][DK / 32], fv[2][2], fk[NST][2], fw[NST][2];
#pragma unroll
        for (int kk = 0; kk < DK / 32; ++kk) { fa[kk] = ldsfrag(QD + (16 * tr + r) * QS + 32 * kk + quad * 8);
            fs[0][kk] = ldsfrag(ST + (16 * tc0 + r) * QS + 32 * kk + quad * 8); fs[1][kk] = ldsfrag(ST + (16 * (tc0 + 1) + r) * QS + 32 * kk + quad * 8); }
#pragma unroll
        for (int q = 0; q < 2; ++q) { fv[q][0] = ldsfrag(VT + (16 * (tc0 + q) + r) * TS + quad * 8); fv[q][1] = ldsfrag(VT + (16 * (tc0 + q) + r) * TS + 32 + quad * 8); }
#pragma unroll
        for (int q = 0; q < NST; ++q) { fk[q][0] = ldsfrag(KDT + (16 * sdt[q] + r) * TS + quad * 8); fk[q][1] = ldsfrag(KDT + (16 * sdt[q] + r) * TS + 32 + quad * 8);
            fw[q][0] = ldsfrag(VT + (16 * sct[q] + r) * TS + quad * 8); fw[q][1] = ldsfrag(VT + (16 * sct[q] + r) * TS + 32 + quad * 8); }
        const bf16x8 af0 = ldsfrag(AL + (16 * tr + r) * TS + quad * 8), af1 = ldsfrag(AL + (16 * tr + r) * TS + 32 + quad * 8);
        f32x4 dcv[NST];
#pragma unroll
        for (int q = 0; q < NST; ++q) dcv[q] = *(const LAS f32x4*)(DEC + 16 * sdt[q] + quad * 4);
        f32x4 oa0 = {0.f, 0.f, 0.f, 0.f}, oa1 = {0.f, 0.f, 0.f, 0.f};
#pragma unroll
        for (int kk = 0; kk < DK / 32; ++kk) { oa0 = MFMA16(fa[kk], fs[0][kk], oa0); oa1 = MFMA16(fa[kk], fs[1][kk], oa1); }
        oa0 = MFMA16(af0, fv[0][0], oa0); oa1 = MFMA16(af0, fv[1][0], oa1);
        oa0 = MFMA16(af1, fv[0][1], oa0); oa1 = MFMA16(af1, fv[1][1], oa1);
#pragma unroll
        for (int q = 0; q < NST; ++q) Sacc[q] = Sacc[q] * dcv[q];
#pragma unroll
        for (int q = 0; q < NST; ++q) Sacc[q] = MFMA16(fk[q][0], fw[q][0], Sacc[q]);
#pragma unroll
        for (int q = 0; q < NST; ++q) Sacc[q] = MFMA16(fk[q][1], fw[q][1], Sacc[q]);
#pragma unroll
        for (int j = 0; j < 4; ++j) { OST[(quad * 4 + j) * 32 + r] = (bf16_t)f2bf(oa0[j]); OST[(quad * 4 + j) * 32 + 16 + r] = (bf16_t)f2bf(oa1[j]); }
        LDS_WAIT();
        if (DRYRUN == 0) *(u32x4*)(pbase + (size_t)(n * 64 + 16 * tr + (lane >> 2)) * PLD + cv + 16 * tc0 + (lane & 3) * 8) = *(const LAS u32x4*)(OST + (lane >> 2) * 32 + (lane & 3) * 8);
        LDS_BARRIER();
#pragma unroll
        for (int q = 0; q < NST; ++q) { u32x2 o; o.x = pk2(Sacc[q][0], Sacc[q][1]); o.y = pk2(Sacc[q][2], Sacc[q][3]);
            *(LAS u32x2*)(ST + (16 * sct[q] + r) * QS + 16 * sdt[q] + quad * 4) = o; }
    };
    for (int n = 0; n < NCHUNK; n += 2) { GLA_CHUNK(P0, n); GLA_CHUNK(P1, n + 1); }
#undef GLA_LOAD
#undef GLA_CHUNK
    LDS_BARRIER();
}

template <int DRYRUN = 0>
__device__ __forceinline__ void chain_gdn(LAS unsigned char* lds, const MixArgs& A, int b, int h, int half, const bf16_t* Taux, const bf16_t* SCaux) {
    constexpr int QS = 136, TS = 72, VS = 68;
    int tid = threadIdx.x; asm volatile("" : "+v"(tid));
    const int lane = tid & 63, w = __builtin_amdgcn_readfirstlane(tid >> 6), r = lane & 15, quad = lane >> 4;
    LAS bf16_t* QD = (LAS bf16_t*)lds; LAS bf16_t* KBG = QD + 64 * QS; LAS bf16_t* ST = KBG + 64 * QS; LAS bf16_t* KDT = ST + 64 * QS; LAS bf16_t* XT = KDT + 128 * TS; LAS bf16_t* VNT = XT + 64 * TS;
    LAS bf16_t* VC = VNT + 64 * TS; LAS bf16_t* TL = VC + 64 * TS; LAS bf16_t* SCL = TL + 64 * TS; LAS float* CDL = (LAS float*)(SCL + 64 * TS); LAS bf16_t* OST = (LAS bf16_t*)(CDL + 4) + w * 512;
    const bf16_t* seqrow = A.proj + (size_t)b * SEQ * PLD;
    const float* decg = A.dec + DEC_GDN_OFF / 4 + (size_t)(b * 4 + h) * NCHUNK;
    const int tr = w >> 1, tc0 = 2 * (w & 1);
    f32x4 Sacc[4];
#pragma unroll
    for (int q = 0; q < 4; ++q) Sacc[q] = (f32x4){0.f, 0.f, 0.f, 0.f};
    for (int i = tid; i < 64 * QS / 2; i += 512) ((LAS unsigned*)ST)[i] = 0u;
    bf16_t* obase = A.odn + (size_t)b * SEQ * 512 + h * 128 + half * 64;
    struct Pre { u32x4 qd[2], kb[2], kd[2], vc, tm, sm; float cd; };
    Pre P0, P1;
#define GDN_LOAD(P, n_) do { const bf16_t* cr = seqrow + (size_t)(n_) * 64 * PLD + h * 128; \
        _Pragma("unroll") for (int k = 0; k < 2; ++k) { const int p = tid + 512 * k; const bf16_t* rp = cr + (size_t)(p >> 4) * PLD + (p & 15) * 8; \
            P.qd[k] = *(const u32x4*)(rp + C_DNQ); P.kb[k] = *(const u32x4*)(rp + C_DNK); P.kd[k] = *(const u32x4*)(rp + C_DNV); } \
        P.vc = *(const u32x4*)(obase + (size_t)((n_) * 64 + (tid >> 3)) * 512 + (tid & 7) * 8); \
        P.cd = decg[(n_)]; \
        P.tm = *(const u32x4*)(Taux + (size_t)(n_) * 4096 + tid * 8); P.sm = *(const u32x4*)(SCaux + (size_t)(n_) * 4096 + tid * 8); } while (0)
    GDN_LOAD(P0, 0); GDN_LOAD(P1, 1);
#define GDN_CHUNK(P, n) do { \
        *(LAS u32x4*)(TL + (tid >> 3) * TS + (tid & 7) * 8) = P.tm; *(LAS u32x4*)(SCL + (tid >> 3) * TS + (tid & 7) * 8) = P.sm; if (tid == 0) CDL[0] = P.cd; \
        _Pragma("unroll") for (int k = 0; k < 2; ++k) { const int p = tid + 512 * k, row = p >> 4, seg = p & 15; \
            *(LAS u32x4*)(QD + row * QS + seg * 8) = P.qd[k]; *(LAS u32x4*)(KBG + row * QS + seg * 8) = P.kb[k]; \
            *(LAS u32x4*)(KDT + (2 * row + (seg >> 3)) * TS + (seg & 7) * 8) = P.kd[k]; } \
        *(LAS u32x4*)(VC + (tid >> 3) * TS + (tid & 7) * 8) = P.vc; \
        { const int nn = ((n) + 2 < NCHUNK) ? (n) + 2 : NCHUNK - 1; GDN_LOAD(P, nn); } \
        gdn_body((n)); } while (0)
    auto gdn_body = [&](int n) __attribute__((always_inline)) {
        LDS_BARRIER();
        bf16x8 fs[2][4], fq[4];
        {   bf16x8 fkb[4];
#pragma unroll
            for (int kk = 0; kk < 4; ++kk) { fkb[kk] = ldsfrag(KBG + (16 * tr + r) * QS + 32 * kk + quad * 8); fq[kk] = ldsfrag(QD + (16 * tr + r) * QS + 32 * kk + quad * 8);
                fs[0][kk] = ldsfrag(ST + (16 * tc0 + r) * QS + 32 * kk + quad * 8); fs[1][kk] = ldsfrag(ST + (16 * (tc0 + 1) + r) * QS + 32 * kk + quad * 8); }
            float vc0[4], vc1[4];
#pragma unroll
            for (int j = 0; j < 4; ++j) { vc0[j] = bf1(VC[(16 * tr + quad * 4 + j) * TS + 16 * tc0 + r]); vc1[j] = bf1(VC[(16 * tr + quad * 4 + j) * TS + 16 * (tc0 + 1) + r]); }
            f32x4 x0 = {0.f, 0.f, 0.f, 0.f}, x1 = {0.f, 0.f, 0.f, 0.f};
#pragma unroll
            for (int kk = 0; kk < 4; ++kk) { x0 = MFMA16(fkb[kk], fs[0][kk], x0); x1 = MFMA16(fkb[kk], fs[1][kk], x1); }
            u32x2 o; o.x = pk2(vc0[0] - x0[0], vc0[1] - x0[1]); o.y = pk2(vc0[2] - x0[2], vc0[3] - x0[3]);
            *(LAS u32x2*)(XT + (16 * tc0 + r) * TS + 16 * tr + quad * 4) = o;
            o.x = pk2(vc1[0] - x1[0], vc1[1] - x1[1]); o.y = pk2(vc1[2] - x1[2], vc1[3] - x1[3]);
            *(LAS u32x2*)(XT + (16 * (tc0 + 1) + r) * TS + 16 * tr + quad * 4) = o;
        }
        LDS_BARRIER();
        {   const bf16x8 tf0 = ldsfrag(TL + (16 * tr + r) * TS + quad * 8), tf1 = ldsfrag(TL + (16 * tr + r) * TS + 32 + quad * 8);
            const bf16x8 b00 = ldsfrag(XT + (16 * tc0 + r) * TS + quad * 8), b01 = ldsfrag(XT + (16 * tc0 + r) * TS + 32 + quad * 8);
            const bf16x8 b10 = ldsfrag(XT + (16 * (tc0 + 1) + r) * TS + quad * 8), b11 = ldsfrag(XT + (16 * (tc0 + 1) + r) * TS + 32 + quad * 8);
            f32x4 v0 = {0.f, 0.f, 0.f, 0.f}, v1 = {0.f, 0.f, 0.f, 0.f};
            v0 = MFMA16(tf0, b00, v0); v1 = MFMA16(tf0, b10, v1); v0 = MFMA16(tf1, b01, v0); v1 = MFMA16(tf1, b11, v1);
            u32x2 o; o.x = pk2(v0[0], v0[1]); o.y = pk2(v0[2], v0[3]);
            *(LAS u32x2*)(VNT + (16 * tc0 + r) * TS + 16 * tr + quad * 4) = o;
            o.x = pk2(v1[0], v1[1]); o.y = pk2(v1[2], v1[3]);
            *(LAS u32x2*)(VNT + (16 * (tc0 + 1) + r) * TS + 16 * tr + quad * 4) = o;
        }
        LDS_BARRIER();
        {   bf16x8 fw[4][2], fk[2];
#pragma unroll
            for (int q = 0; q < 4; ++q) { fw[q][0] = ldsfrag(VNT + (16 * q + r) * TS + quad * 8); fw[q][1] = ldsfrag(VNT + (16 * q + r) * TS + 32 + quad * 8); }
            fk[0] = ldsfrag(KDT + (16 * w + r) * TS + quad * 8); fk[1] = ldsfrag(KDT + (16 * w + r) * TS + 32 + quad * 8);
            const bf16x8 sf0 = ldsfrag(SCL + (16 * tr + r) * TS + quad * 8), sf1 = ldsfrag(SCL + (16 * tr + r) * TS + 32 + quad * 8); const float cd = CDL[0];
            f32x4 oa0 = {0.f, 0.f, 0.f, 0.f}, oa1 = {0.f, 0.f, 0.f, 0.f};
#pragma unroll
            for (int kk = 0; kk < 4; ++kk) { oa0 = MFMA16(fq[kk], fs[0][kk], oa0); oa1 = MFMA16(fq[kk], fs[1][kk], oa1); }
#pragma unroll
            for (int q = 0; q < 4; ++q) Sacc[q] = Sacc[q] * cd;
#pragma unroll
            for (int q = 0; q < 4; ++q) Sacc[q] = MFMA16(fk[0], fw[q][0], Sacc[q]);
            const bf16x8 g00 = (tc0 == 0) ? fw[0][0] : fw[2][0], g01 = (tc0 == 0) ? fw[0][1] : fw[2][1], g10 = (tc0 == 0) ? fw[1][0] : fw[3][0], g11 = (tc0 == 0) ? fw[1][1] : fw[3][1];
            oa0 = MFMA16(sf0, g00, oa0); oa1 = MFMA16(sf0, g10, oa1);
#pragma unroll
            for (int q = 0; q < 4; ++q) Sacc[q] = MFMA16(fk[1], fw[q][1], Sacc[q]);
            oa0 = MFMA16(sf1, g01, oa0); oa1 = MFMA16(sf1, g11, oa1);
#pragma unroll
            for (int j = 0; j < 4; ++j) { OST[(quad * 4 + j) * 32 + r] = (bf16_t)f2bf(oa0[j]); OST[(quad * 4 + j) * 32 + 16 + r] = (bf16_t)f2bf(oa1[j]); }
            LDS_WAIT();
            if (DRYRUN == 0) *(u32x4*)(obase + (size_t)(n * 64 + 16 * tr + (lane >> 2)) * 512 + 16 * tc0 + (lane & 3) * 8) = *(const LAS u32x4*)(OST + (lane >> 2) * 32 + (lane & 3) * 8);
        }
        LDS_BARRIER();
#pragma unroll
        for (int q = 0; q < 4; ++q) { u32x2 o; o.x = pk2(Sacc[q][0], Sacc[q][1]); o.y = pk2(Sacc[q][2], Sacc[q][3]);
            *(LAS u32x2*)(ST + (16 * q + r) * QS + 16 * w + quad * 4) = o; }
    };
    for (int n = 0; n < NCHUNK; n += 2) { GDN_CHUNK(P0, n); GDN_CHUNK(P1, n + 1); }
#undef GDN_LOAD
#undef GDN_CHUNK
    LDS_BARRIER();
}

#define XB_TMO      128
#define XB_XCNT(j)  (256  + 64 * (j))
#define XB_XSUB(j)  (1280 + 64 * (j))
#define XB_XGEN(j)  (2304 + 64 * (j))
#define XB_TOP      3328
#define XB_TOPGEN   3392
#define XCD_BAR_WORDS 3456
#define XB_SPIN_CAP (1u << 18)

__device__ __forceinline__ unsigned xb_ld(unsigned* p)              { return __hip_atomic_load(p, __ATOMIC_RELAXED, __HIP_MEMORY_SCOPE_AGENT); }
__device__ __forceinline__ unsigned xb_add(unsigned* p, unsigned v) { return __hip_atomic_fetch_add(p, v, __ATOMIC_RELAXED, __HIP_MEMORY_SCOPE_AGENT); }
__device__ __forceinline__ unsigned xb_xcc_id() { return (unsigned)__builtin_amdgcn_s_getreg((3 << 11) | 20) & 0xFu; }
#define XB_SPIN(cond, bar) do { unsigned _sp = 0; while (cond) { __builtin_amdgcn_s_sleep(1); \
    if ((++_sp & 255u) == 0u) { if (xb_ld(&(bar)[XB_TMO])) break; if (_sp > XB_SPIN_CAP) { atomicAdd(&(bar)[XB_TMO], 1u); break; } } } } while (0)

struct XcdBarrier {
    unsigned* bar; unsigned x;
    volatile LAS unsigned* st;
};

__device__ __forceinline__ XcdBarrier xcd_barrier_post(unsigned* bar, volatile LAS unsigned* st) {
    XcdBarrier b; b.bar = bar; b.x = xb_xcc_id(); b.st = st;
    if (threadIdx.x == 0) (void)xb_add(&bar[XB_XCNT(b.x)], 1u);
    return b;
}
__device__ __forceinline__ void xcd_barrier_complete(unsigned* bar, unsigned x, unsigned& nloc, unsigned& nx) {
    const unsigned G = gridDim.x * gridDim.y * gridDim.z;
    unsigned sum, cnt, mine, sp = 0u;
    for (;;) {
        sum = 0u; cnt = 0u; mine = 0u;
#pragma unroll
        for (unsigned j = 0; j < 16; ++j) { const unsigned c = xb_ld(&bar[XB_XCNT(j)]); sum += c; cnt += (c > 0u) ? 1u : 0u; mine = (j == x) ? c : mine; }
        if (sum == G) break;
        __builtin_amdgcn_s_sleep(1);
        if ((++sp & 255u) == 0u) { if (xb_ld(&bar[XB_TMO])) break; if (sp > XB_SPIN_CAP) { atomicAdd(&bar[XB_TMO], 1u); break; } }
    }
    nloc = mine > 0u ? mine : 1u; nx = cnt > 0u ? cnt : 1u;
}

__device__ __forceinline__ void xcd_barrier(const XcdBarrier& b) {
    asm volatile("s_waitcnt vmcnt(0)" ::: "memory");
    __syncthreads();
    if (threadIdx.x == 0) {
        unsigned* bar = b.bar;
        __builtin_amdgcn_s_waitcnt(0);
        unsigned nloc = b.st[0], nx = b.st[1];
        if (nloc == 0u) { xcd_barrier_complete(bar, b.x, nloc, nx); b.st[0] = nloc; b.st[1] = nx; }
        const unsigned old = xb_add(&bar[XB_XSUB(b.x)], 1u);
        const unsigned gen = old / nloc;
        if (old + 1u == (gen + 1u) * nloc) {
            __builtin_amdgcn_fence(__ATOMIC_RELEASE, "agent");
            asm volatile("s_waitcnt vmcnt(0)" ::: "memory");
            const unsigned og = xb_add(&bar[XB_TOP], 1u);
            const unsigned tg = og / nx;
            if (og + 1u == (tg + 1u) * nx) xb_add(&bar[XB_TOPGEN], 1u);
            else XB_SPIN(xb_ld(&bar[XB_TOPGEN]) == tg, bar);
            __builtin_amdgcn_fence(__ATOMIC_ACQUIRE, "agent");
            xb_add(&bar[XB_XGEN(b.x)], 1u);
            asm volatile("s_waitcnt vmcnt(0)" ::: "memory");
        } else {
            XB_SPIN(xb_ld(&bar[XB_XGEN(b.x)]) == gen, bar);
            __builtin_amdgcn_fence(__ATOMIC_ACQUIRE, "agent");
            asm volatile("s_waitcnt vmcnt(0)" ::: "memory");
        }
    }
    __syncthreads();
}

__global__ void __launch_bounds__(512, 2) fwd_megakernel(Args args) {
    extern __shared__ __attribute__((aligned(16))) unsigned char lds_raw[];
    LAS unsigned char* lds = (LAS unsigned char*)lds_raw;
    cg::grid_group grid = cg::this_grid();
    const int G = gridDim.x, bx = blockIdx.x, NGW = G * 8;
    volatile LAS unsigned* bst = (volatile LAS unsigned*)(lds + 131072 + 64);
    if (threadIdx.x < 4) bst[threadIdx.x] = 0u;
    __syncthreads();
    const XcdBarrier xbar = xcd_barrier_post((unsigned*)(args.ws + WS_CTL), bst);
#define OPAQUE_TID() int tid = threadIdx.x; asm volatile("" : "+v"(tid)); const int lane = tid & 63, wave = __builtin_amdgcn_readfirstlane(tid >> 6), gw = bx * 8 + wave; (void)lane; (void)gw
    unsigned char* ws = args.ws;
    const float* x_in = args.in[0];
    float* xres = args.out;
    bf16_t* HB = (bf16_t*)(ws + WS_HB);
    bf16_t* PROJ = (bf16_t*)(ws + WS_PROJ);
    bf16_t* ODN = (bf16_t*)(ws + WS_ODN);
    bf16_t* UH = (bf16_t*)(ws + WS_U);
    bf16_t* GACT = (bf16_t*)(ws + WS_GACT);
    bf16_t* XB2 = (bf16_t*)(ws + WS_XB2);
    float* SSQ1 = (float*)(ws + WS_SSQ1); float* SSQ2 = (float*)(ws + WS_SSQ2);

    {
        OPAQUE_TID();
        LAS float* scr = (LAS float*)(lds + wave * 16384);
#define CONVERT_WIN(l_, gw_, ngw_) do { unsigned char* lw_ = ws + WS_W + (size_t)(l_) * LW_BYTES; \
            transpose_weight(args.in[2] + (size_t)(l_) * DM * INW, DM, INW, RmWin{(bf16_t*)(lw_ + LW_WIN), (bf16_t*)(lw_ + LW_WG)}, scr, gw_, ngw_, lane, args.in[1] + (size_t)(l_) * DM); } while (0)
#define CONVERT_REST(l_, gw_, ngw_) do { unsigned char* lw_ = ws + WS_W + (size_t)(l_) * LW_BYTES; \
            for (int n_ = 0; n_ < 3; ++n_) \
                transpose_weight(args.in[12] + ((size_t)(l_) * 3 + n_) * 512 * DM, 512, DM, RmPlain{(bf16_t*)(lw_ + LW_WBR) + (size_t)n_ * DM * 512, 512}, scr, gw_, ngw_, lane); \
            transpose_weight(args.in[14] + (size_t)(l_) * DM * DM, DM, DM, RmPlain{(bf16_t*)(lw_ + LW_WOUT), DM}, scr, gw_, ngw_, lane); \
            transpose_weight(args.in[16] + (size_t)(l_) * DM * UPN, DM, UPN, RmUp{(bf16_t*)(lw_ + LW_WUP)}, scr, gw_, ngw_, lane, args.in[15] + (size_t)(l_) * DM); \
            transpose_weight(args.in[19] + (size_t)(l_) * FFH * DM, FFH, DM, RmPlain{(bf16_t*)(lw_ + LW_WDN), FFH}, scr, gw_, ngw_, lane); } while (0)
        CONVERT_WIN(0, gw, NGW);
        if (G <= 192) { CONVERT_REST(0, gw, NGW); CONVERT_WIN(1, gw, NGW); CONVERT_REST(1, gw, NGW); }
        conv_rows_bf16(x_in, HB, SSQ1, gw, NGW, lane);
        for (int i = bx * 512 + tid; i < T; i += G * 512) SSQ2[i] = 0.f;
    }
    grid.sync();

    for (int l = 0; l < DEPTH; ++l) {
        unsigned char* lw = ws + WS_W + (size_t)l * LW_BYTES;
        const float* xi = (l == 0) ? x_in : xres;
        { pg8::Gemm g{HB, (const bf16_t*)(lw + LW_WIN), DM, DM, 0, 0, 0}; pg8::StaticOrder S; S.init(T, PLD, G, bx);
          pg8::EpiProj E{PROJ, PLD, (bf16_t*)(ws + WS_HALO), SSQ1}; pg8::gemm_phase(lds, g, S, E); }
        xcd_barrier(xbar);
        {
            MixArgs A{PROJ, ODN, (const bf16_t*)(ws + WS_HALO), (float*)(ws + WS_DEC), args.in[3], l, args.in[5] + (size_t)l * 16 * 256, args.in[6] + (size_t)l * 256, args.in[8] + (size_t)l * 4 * 1536, args.in[9] + (size_t)l * 4, args.in[10] + (size_t)l * 4};
            bf16_t* AUX = (l == 0) ? (bf16_t*)xres : HB;
            constexpr size_t SLOT_E = AUX_SLOT / 2;
#if CH_GLA || CH_GDN
            for (int it = bx; it < 3 * 4096; it += G) {
                const int mix = it % 3, ch = it / 3, n = ch & 127, bh = ch >> 7, b = bh >> 2, h = bh & 3;
                if (mix == 0) { if (CH_GLA) prep_gla_item<0>(lds, A, b, h, n, AUX + 0 * SLOT_E + (size_t)ch * 4096); }
                else if (mix == 1) { if (CH_GLA) prep_gla_item<1>(lds, A, b, h, n, AUX + 1 * SLOT_E + (size_t)ch * 4096); }
                else { if (CH_GDN) prep_gdn_item(lds, A, b, h, n, AUX + 2 * SLOT_E + (size_t)ch * 4096, AUX + 3 * SLOT_E + (size_t)ch * 4096); }
            }
            xcd_barrier(xbar);
#endif
            for (int item = bx; item < 192; item += G) {
                const int mix = item % 3, rest = item / 3, half = rest & 1, bh = rest >> 1, b = bh >> 2, h = bh & 3;
                if (mix == 0) { if (CH_GLA) chain_gla<0>(lds, A, b, h, half, AUX + 0 * SLOT_E + (size_t)bh * 128 * 4096); else mixer_chain<0>(lds, A, b, h, half); }
                else if (mix == 1) { if (CH_GLA) chain_gla<1>(lds, A, b, h, half, AUX + 1 * SLOT_E + (size_t)bh * 128 * 4096); else mixer_chain<1>(lds, A, b, h, half); }
                else { if (CH_GDN) chain_gdn(lds, A, b, h, half, AUX + 2 * SLOT_E + (size_t)bh * 128 * 4096, AUX + 3 * SLOT_E + (size_t)bh * 128 * 4096); else mixer_chain<2>(lds, A, b, h, half); }
            }
            if (bx >= 192 && l == 0) {
                OPAQUE_TID(); LAS float* scr = (LAS float*)(lds + wave * 16384);
                CONVERT_REST(0, (bx - 192) * 8 + wave, (G - 192) * 8); CONVERT_WIN(1, (bx - 192) * 8 + wave, (G - 192) * 8); CONVERT_REST(1, (bx - 192) * 8 + wave, (G - 192) * 8);
            }
        }
        xcd_barrier(xbar);
        { OPAQUE_TID(); hnorm_phase(PROJ, ODN, args.in[4] + (size_t)l * 128, args.in[7] + (size_t)l * 128, args.in[11] + (size_t)l * 128, gw, NGW, lane);
          if (l != 0) conv_rows_bf16(xi, HB, nullptr, gw, NGW, lane);
        }
        xcd_barrier(xbar);
        { pg8::Gemm g{HB, (const bf16_t*)(lw + LW_WG), DM, DM, 0, 0, 0}; pg8::StaticOrder S; S.init(T, 3072, G, bx);
          pg8::EpiGate E{PROJ, args.in[13] + (size_t)l * 3072, SSQ1}; pg8::gemm_phase(lds, g, S, E); }
        xcd_barrier(xbar);
        { pg8::Gemm g{PROJ + C_HGI, (const bf16_t*)(lw + LW_WBR), PLD, 512, (size_t)DM * 512 * 2, (size_t)(C_GLV - C_HGI) * 2, (size_t)(C_DNV - C_HGI) * 2};
          pg8::BranchOrder S; S.base.init(T, DM, G, bx);
          pg8::EpiBranch E{PROJ, HB}; pg8::gemm_phase(lds, g, S, E); }
        xcd_barrier(xbar);
        { pg8::Gemm g{HB, (const bf16_t*)(lw + LW_WOUT), DM, DM, 0, 0, 0}; pg8::StaticOrder S; S.init(T, DM, G, bx);
          pg8::EpiResid E{xi, xres, XB2, SSQ2}; pg8::gemm_phase(lds, g, S, E); }
        xcd_barrier(xbar);
        for (int hf = 0; hf < 2; ++hf) {
            { pg8::Gemm g{XB2 + (size_t)hf * TH * DM, (const bf16_t*)(lw + LW_WUP), DM, DM, 0, 0, 0}; pg8::StaticOrder S; S.init(TH, UPN, G, bx);
              pg8::EpiBf16 E{UH, UPN, SSQ2 + (size_t)hf * TH}; pg8::gemm_phase(lds, g, S, E); }
            xcd_barrier(xbar);
            { OPAQUE_TID(); convgate_phase(UH, GACT, args.in[17] + (size_t)l * 3 * UPN, args.in[18] + (size_t)l * UPN, bx * 512 + tid, G * 512);
              if (l + 1 < DEPTH) { float* z = (hf == 0) ? SSQ1 : SSQ2; for (int i = bx * 512 + tid; i < T; i += G * 512) z[i] = 0.f; } }
            xcd_barrier(xbar);
            { pg8::Gemm g{GACT, (const bf16_t*)(lw + LW_WDN), FFH, FFH, 0, 0, 0}; pg8::StaticOrder S; S.init(TH, DM, G, bx);
              pg8::EpiResid E{xres + (size_t)hf * TH * DM, xres + (size_t)hf * TH * DM, (l + 1 < DEPTH) ? HB + (size_t)hf * TH * DM : nullptr, SSQ1 + (size_t)hf * TH}; pg8::gemm_phase(lds, g, S, E); }
            if (hf == 1) xcd_barrier(xbar);
        }
    }
    { OPAQUE_TID(); norm_rows_f32_inplace(xres, args.in[20], gw, NGW, lane); }
}

extern "C" void kernel_launch(void* const* d_in, const int* in_sizes, int n_in, void* d_out, int out_size, void* d_ws, size_t ws_size, hipStream_t stream) {
    static int grid = 0;
    if (grid == 0) {
        if (n_in != 21 || out_size != T * DM || ws_size < 1024 * MiB) { fprintf(stderr, "kernel_launch: unexpected shapes (n_in %d out %d ws %zu)\n", n_in, out_size, ws_size); grid = -1; return; }
        int dev = 0, cus = 0, per_cu = 0;
        hipGetDevice(&dev); hipDeviceGetAttribute(&cus, hipDeviceAttributeMultiprocessorCount, dev);
        if (hipFuncSetAttribute((const void*)fwd_megakernel, hipFuncAttributeMaxDynamicSharedMemorySize, LDS_BYTES) != hipSuccess) { fprintf(stderr, "kernel_launch: hipFuncSetAttribute failed\n"); grid = -1; return; }
        if (hipOccupancyMaxActiveBlocksPerMultiprocessor(&per_cu, (const void*)fwd_megakernel, 512, LDS_BYTES) != hipSuccess || per_cu < 1) { fprintf(stderr, "kernel_launch: occupancy query %d\n", per_cu); per_cu = 1; }
        (void)hipGetLastError();
        grid = cus;
    }
    if (grid < 0) return;
    if (hipMemsetAsync((char*)d_ws + WS_CTL, 0, CTL_BYTES, stream) != hipSuccess) { fprintf(stderr, "kernel_launch: memset failed\n"); return; }
    Args a{};
    for (int i = 0; i < 21; ++i) a.in[i] = (const float*)d_in[i];
    a.out = (float*)d_out; a.ws = (unsigned char*)d_ws;
    void* kargs[] = {&a};
    hipError_t e = hipLaunchCooperativeKernel((const void*)fwd_megakernel, dim3(grid), dim3(512), kargs, LDS_BYTES, stream);
    if (e != hipSuccess) fprintf(stderr, "cooperative launch failed: %s (grid %d)\n", hipGetErrorString(e), grid);
}
```
